# Optimizing an MI355X kernel written in HIP

```python
import math
import jax, jax.numpy as jnp
from jax import lax
import numpy as np

D_MODEL = 2048
BATCH = 4
SEQ = 4096
DEPTH = 4

GRID_W = 64
HEAD_DIM = 128
N_Q_HEADS = 16
N_KV_HEADS = 4
GROUP = N_Q_HEADS // N_KV_HEADS
ATTN_WIDTH = N_Q_HEADS * HEAD_DIM
KV_WIDTH = N_KV_HEADS * HEAD_DIM
CONV_WIDTH = D_MODEL
CONV_K = 3
D_FF = 4 * D_MODEL
Q_BLOCK = 128
ROPE_THETA = 10000.0
RMS_EPS = 1e-6
AXIS_DIM = HEAD_DIM // 2
N_FREQ = AXIS_DIM // 2
IN_SPLITS = (CONV_WIDTH, CONV_WIDTH, CONV_WIDTH, ATTN_WIDTH, KV_WIDTH, KV_WIDTH, D_MODEL, D_MODEL)
IN_WIDTH = sum(IN_SPLITS)
IN_OFFSETS = tuple(int(o) for o in np.cumsum(IN_SPLITS)[:-1])

kernel_name = 'hybrid_shortconv_gqa_axial_encoder'


def rmsnorm(x, g):
    xf = x.astype(jnp.float32)
    y = xf * lax.rsqrt(jnp.mean(xf * xf, axis=-1, keepdims=True) + RMS_EPS)
    return (y * g.astype(jnp.float32)).astype(x.dtype)


def axial_rope_tables(seq_len):
    rows = seq_len // GRID_W
    row_idx = jnp.repeat(jnp.arange(rows, dtype=jnp.int32), GRID_W)
    col_idx = jnp.tile(jnp.arange(GRID_W, dtype=jnp.int32), rows)
    inv_freq = ROPE_THETA ** (-jnp.arange(0, AXIS_DIM, 2, dtype=jnp.float32) / AXIS_DIM)
    ang = jnp.stack([row_idx.astype(jnp.float32)[:, None] * inv_freq,
                     col_idx.astype(jnp.float32)[:, None] * inv_freq], axis=1)
    return jnp.cos(ang), jnp.sin(ang)


def apply_axial_rope(x, cos, sin):
    b, s, h, _ = x.shape
    xr = x.astype(jnp.float32).reshape(b, s, h, 2, 2, N_FREQ)
    x1, x2 = xr[..., 0, :], xr[..., 1, :]
    c, sn = cos[None, :, None], sin[None, :, None]
    out = jnp.stack([x1 * c - x2 * sn, x2 * c + x1 * sn], axis=-2)
    return out.reshape(b, s, h, HEAD_DIM).astype(x.dtype)


def short_conv_mixer(conv_b, conv_c, h_in, w_conv, w_out):
    u = conv_c * h_in
    up = jnp.pad(u, ((0, 0), (1, 1), (0, 0)))
    conv = w_conv[0] * up[:, :-2] + w_conv[1] * up[:, 1:-1] + w_conv[2] * up[:, 2:]
    return (conv_b * conv) @ w_out


def block_gqa(q, k, v):
    b, s, _, _ = q.shape
    nb = s // Q_BLOCK
    scale = 1.0 / math.sqrt(HEAD_DIM)
    qb = (q * scale).reshape(b, nb, Q_BLOCK, N_KV_HEADS, GROUP, HEAD_DIM).transpose(1, 0, 2, 3, 4, 5)

    def one_block(q_blk):
        scores = jnp.einsum('bqkgd,bskd->bkgqs', q_blk, k).astype(jnp.float32)
        p = jax.nn.softmax(scores, axis=-1).astype(v.dtype)
        return jnp.einsum('bkgqs,bskd->bqkgd', p, v)

    o = lax.map(one_block, qb)
    return o.transpose(1, 0, 2, 3, 4, 5).reshape(b, s, ATTN_WIDTH)


def setup_inputs(seed: int = 0) -> dict:
    key = jax.random.key(seed)
    ks = jax.random.split(key, 16)
    f32 = jnp.float32
    nrm = lambda k, shape, scale: jax.random.normal(k, shape, f32) * scale
    gain = lambda k, shape: 1.0 + 0.02 * jax.random.normal(k, shape, f32)
    return {
        'x': jax.random.normal(ks[0], (BATCH, SEQ, D_MODEL), f32),
        'norm_mix_pre': gain(ks[1], (DEPTH, D_MODEL)),
        'w_in': nrm(ks[2], (DEPTH, D_MODEL, IN_WIDTH), D_MODEL ** -0.5),
        'gate_bias': nrm(ks[3], (DEPTH, 2 * D_MODEL), 0.01),
        'conv_w': nrm(ks[4], (DEPTH, CONV_K, CONV_WIDTH), CONV_K ** -0.5),
        'q_norm': gain(ks[5], (DEPTH, HEAD_DIM)),
        'k_norm': gain(ks[6], (DEPTH, HEAD_DIM)),
        'w_out_conv': nrm(ks[7], (DEPTH, CONV_WIDTH, D_MODEL), CONV_WIDTH ** -0.5),
        'w_out_attn': nrm(ks[8], (DEPTH, ATTN_WIDTH, D_MODEL), ATTN_WIDTH ** -0.5),
        'w_merge': nrm(ks[9], (DEPTH, D_MODEL, D_MODEL), D_MODEL ** -0.5),
        'norm_mix_post': gain(ks[10], (DEPTH, D_MODEL)),
        'norm_mlp_pre': gain(ks[11], (DEPTH, D_MODEL)),
        'w_up': nrm(ks[12], (DEPTH, D_MODEL, D_FF), D_MODEL ** -0.5),
        'w_down': nrm(ks[13], (DEPTH, D_FF, D_MODEL), D_FF ** -0.5),
        'norm_mlp_post': gain(ks[14], (DEPTH, D_MODEL)),
    }


def reference(x, norm_mix_pre, w_in, gate_bias, conv_w, q_norm, k_norm, w_out_conv, w_out_attn,
              w_merge, norm_mix_post, norm_mlp_pre, w_up, w_down, norm_mlp_post):
    b, s, _ = x.shape
    cos, sin = axial_rope_tables(s)
    for l in range(DEPTH):
        h = rmsnorm(x, norm_mix_pre[l])
        z = h @ w_in[l]
        conv_b, conv_c, conv_in, q, k, v, g_a, g_b = jnp.split(z, IN_OFFSETS, axis=-1)

        y_a = short_conv_mixer(conv_b, conv_c, conv_in, conv_w[l], w_out_conv[l])

        q = apply_axial_rope(rmsnorm(q.reshape(b, s, N_Q_HEADS, HEAD_DIM), q_norm[l]), cos, sin)
        k = apply_axial_rope(rmsnorm(k.reshape(b, s, N_KV_HEADS, HEAD_DIM), k_norm[l]), cos, sin)
        v = v.reshape(b, s, N_KV_HEADS, HEAD_DIM)
        y_b = block_gqa(q, k, v) @ w_out_attn[l]

        gates = jax.nn.sigmoid(jnp.concatenate([g_a, g_b], axis=-1) + gate_bias[l])
        gate_a, gate_b = jnp.split(gates, 2, axis=-1)
        mixed = (gate_a * y_a + gate_b * y_b) @ w_merge[l]
        x = x + rmsnorm(mixed, norm_mix_post[l])

        h = rmsnorm(x, norm_mlp_pre[l])
        f = jnp.square(jax.nn.relu(h @ w_up[l])) @ w_down[l]
        x = x + rmsnorm(f, norm_mlp_post[l])
    return x
```

```cpp
#include <hip/hip_runtime.h>
#include <cstdio>
#include <cstdint>

__device__ __forceinline__ int mk_lane() { int l; asm volatile("v_mbcnt_lo_u32_b32 %0, -1, 0\n\tv_mbcnt_hi_u32_b32 %0, -1, %0" : "=v"(l)); return l; }
__device__ __forceinline__ float mk_shfl_xor(float v, int mask, int lane) { return __builtin_bit_cast(float, __builtin_amdgcn_ds_bpermute((lane ^ mask) << 2, __builtin_bit_cast(int, v))); }
#ifndef PG8_RELAX
#define PG8_RELAX 1
#endif
namespace pg8 {
#define PG8_LAS __attribute__((address_space(3)))
typedef unsigned short bf16_t;
typedef short bf16x8 __attribute__((ext_vector_type(8)));
typedef float f32x4 __attribute__((ext_vector_type(4)));
typedef unsigned u32x4 __attribute__((ext_vector_type(4)));
typedef int v8i32 __attribute__((ext_vector_type(8)));
constexpr int BM = 256, BK = 64, HALF = 128, HTB = HALF * BK * 2  , STAGE_BYTES = 8 * HTB, NXCD = 8, WGM = 8;

__host__ __device__ __forceinline__ int lds_byte(int r, int c) { const int st = (r >> 4) * 2 + (c >> 5), rr = r & 15, cc = c & 31, ob = rr * 64 + cc * 2; return st * 1024 + (ob ^ (((ob >> 9) & 1) << 5)); }
__host__ __device__ __forceinline__ void stage_rc(int b, int& R, int& C) { const int st = b / 1024, sb = b % 1024, swz = sb ^ (((sb >> 9) & 1) << 5); R = (st >> 1) * 16 + swz / 64; C = (st & 1) * 32 + (swz % 64) / 2; }
__host__ __device__ __forceinline__ int perm32(int rho) { const int n = rho >> 4, i = rho & 15; return 8 * (i >> 2) + 4 * n + (i & 3); }

struct Unit { int pm, pn; };
struct Gemm { const bf16_t* A; const bf16_t* Bt; int M, N, K; };

struct StaticOrder {
    int nM, nN, nwg, G, c, wgm;
    __host__ __device__ void init(int M, int N, int G_, int c_, int wgm_ = WGM) { nM = M / BM; nN = N / BM; nwg = nM * nN; G = G_; c = c_; wgm = wgm_; }
    __host__ __device__ bool next(int i, Unit& u) const {
        const long L = (long)i * G + c; if (L >= nwg) return false;
        int wgid = (int)L; { const int q = nwg / NXCD, r = nwg % NXCD, xcd = wgid % NXCD, off = wgid / NXCD; wgid = (xcd < r ? xcd * (q + 1) : r * (q + 1) + (xcd - r) * q) + off; }
        const int nig = wgm * nN, gid = wgid / nig, fm = gid * wgm, gsz = (nM - fm) < wgm ? (nM - fm) : wgm;
        u.pm = fm + ((wgid % nig) % gsz); u.pn = (wgid % nig) / gsz; return true;
    }
    static constexpr bool DUAL = false;
    __device__ __forceinline__ const char* opA2() const { return nullptr; }
    __device__ __forceinline__ const char* opB2() const { return nullptr; }
    __device__ __forceinline__ void a_ready(const Unit&) const {}
    __device__ __forceinline__ void done(const Unit&) const {}
};
struct DualOrder : StaticOrder {
    const bf16_t* A2; const bf16_t* Bt2;
    static constexpr bool DUAL = true;
    __device__ __forceinline__ const char* opA2() const { return (const char*)A2; }
    __device__ __forceinline__ const char* opB2() const { return (const char*)Bt2; }
};


#ifndef PG8_NT_STORES
#define PG8_NT_STORES 0
#endif
#if PG8_NT_STORES
#define PG8_ST16(p, v) __builtin_nontemporal_store((v), (u32x4*)(p))
#else
#define PG8_ST16(p, v) (*(u32x4*)(p) = (v))
#endif
typedef float f32x2_t __attribute__((ext_vector_type(2)));
typedef __bf16 bf16x2_t __attribute__((ext_vector_type(2)));
__device__ __forceinline__ unsigned cvt_pk_bf16(float lo, float hi) { const f32x2_t v = {lo, hi}; const bf16x2_t b = __builtin_convertvector(v, bf16x2_t); return __builtin_bit_cast(unsigned, b); }
__device__ __forceinline__ float bf_lo(unsigned w) { return __uint_as_float(w << 16); }
__device__ __forceinline__ float bf_hi(unsigned w) { return __uint_as_float(w & 0xffff0000u); }
__device__ __forceinline__ float sigmoid_f(float x) { return __builtin_amdgcn_rcpf(1.0f + __builtin_amdgcn_exp2f(-1.4426950408889634f * x)); }
__device__ __forceinline__ u32x4 pack8(const f32x4 v0, const f32x4 v1) { u32x4 w; w.x = cvt_pk_bf16(v0[0], v0[1]); w.y = cvt_pk_bf16(v0[2], v0[3]); w.z = cvt_pk_bf16(v1[0], v1[1]); w.w = cvt_pk_bf16(v1[2], v1[3]); return w; }

struct EpiZ {
    static constexpr bool PERM = true, AFTER_DRAIN = false, LV = false; static constexpr int NST = 8;
    bf16_t* O; int ldc; const float* rs; const float* qg; const float* kg; const float* rope; float qscale; float eps; PG8_LAS unsigned char* misc;
    __device__ __forceinline__ void operator()(const f32x4 (&acc)[2][2][4][2], const Unit& u, int wr_, int wc_, int, int) const {
        int wr = wr_, wc = wc_; asm volatile("" : "+s"(wr), "+s"(wc));
        const int lane_ = mk_lane(), fr = lane_ & 15, fq = lane_ >> 4;
        const int row0 = u.pm * BM + wr * 64 + fr, gcol0 = u.pn * BM + wc * 32 + 8 * fq;
        float rv[2][4];
#pragma unroll
        for (int ai = 0; ai < 2; ++ai)
#pragma unroll
            for (int m = 0; m < 4; ++m) rv[ai][m] = rs[row0 + ai * HALF + m * 16];
        if (u.pn >= 8 && u.pn < 24) {
            const int col0 = 2048 + HALF * (u.pn - 8) + wc * 32 + 8 * fq;
#pragma unroll
            for (int ai = 0; ai < 2; ++ai)
#pragma unroll
                for (int m = 0; m < 4; ++m) { const float r2 = rv[ai][m] * rv[ai][m]; PG8_ST16(O + (size_t)(row0 + ai * HALF + m * 16) * ldc + col0, pack8(acc[ai][0][m][0] * acc[ai][1][m][0] * r2, acc[ai][0][m][1] * acc[ai][1][m][1] * r2)); }
        } else if (u.pn >= 24 && u.pn < 34) {
            const bool isq = u.pn < 32; const float* gn = isq ? qg : kg;
            const int ax = wc >> 1, f0 = 16 * (wc & 1) + 4 * fq, d1 = 64 * ax + f0;
            const f32x4 g1 = *(const f32x4*)(gn + d1), g2 = *(const f32x4*)(gn + d1 + 32);
            PG8_LAS float* PARTf = (PG8_LAS float*)misc; const PG8_LAS f32x4* PART4 = (const PG8_LAS f32x4*)misc;
#pragma unroll
            for (int ai = 0; ai < 2; ++ai)
#pragma unroll
                for (int bj = 0; bj < 2; ++bj) { float sq[4];
#pragma unroll
                    for (int m = 0; m < 4; ++m) { const f32x4 v0 = acc[ai][bj][m][0], v1 = acc[ai][bj][m][1]; sq[m] = ((v0[0] * v0[0] + v0[1] * v0[1]) + (v0[2] * v0[2] + v0[3] * v0[3])) + ((v1[0] * v1[0] + v1[1] * v1[1]) + (v1[2] * v1[2] + v1[3] * v1[3])); }
                    auto r02 = __builtin_amdgcn_permlane32_swap(__float_as_uint(sq[0]), __float_as_uint(sq[2]), false, false); const float w0 = __uint_as_float(r02[0]) + __uint_as_float(r02[1]);
                    auto r13 = __builtin_amdgcn_permlane32_swap(__float_as_uint(sq[1]), __float_as_uint(sq[3]), false, false); const float w1 = __uint_as_float(r13[0]) + __uint_as_float(r13[1]);
                    auto rr = __builtin_amdgcn_permlane16_swap(__float_as_uint(w0), __float_as_uint(w1), false, false); const float tw = __uint_as_float(rr[0]) + __uint_as_float(rr[1]);
                    PARTf[((((wr * 2 + ai) * 2 + bj) * 64) + (fq * 16 + fr)) * 4 + wc] = tw; }
            asm volatile("s_waitcnt lgkmcnt(0)" ::: "memory"); __builtin_amdgcn_s_barrier(); asm volatile("" ::: "memory");
            const int colh = u.pn * BM - 2048 + d1;
#pragma unroll
            for (int ai = 0; ai < 2; ++ai)
#pragma unroll
                for (int m = 0; m < 4; ++m) { const int row = row0 + ai * HALF + m * 16, t = row & 4095, pos = ax ? (t & 63) : (t >> 6);
                    const f32x4 csa = *(const f32x4*)(rope + (size_t)(pos * 32 + f0) * 2), csb = *(const f32x4*)(rope + (size_t)(pos * 32 + f0) * 2 + 4);
                    const f32x4 cc = {csa[0], csa[2], csb[0], csb[2]}, sn = {csa[1], csa[3], csb[1], csb[3]};
                    const float r = rv[ai][m]; const float epsr = eps * __builtin_amdgcn_rcpf(r * r);
                    bf16_t* rowp = O + (size_t)row * ldc + colh;
#pragma unroll
                    for (int bj = 0; bj < 2; ++bj) { const f32x4 pp = PART4[((wr * 2 + ai) * 2 + bj) * 64 + m * 16 + fr];
                        const float rstd = __builtin_amdgcn_rsqf(((pp[0] + pp[1]) + (pp[2] + pp[3])) * (1.0f / 128.0f) + epsr) * (isq ? qscale : 1.0f);
                        const f32x4 x1 = acc[ai][bj][m][0] * g1 * rstd, x2 = acc[ai][bj][m][1] * g2 * rstd;
                        const f32x4 o1 = x1 * cc - x2 * sn, o2 = x2 * cc + x1 * sn;
                        typedef unsigned u32x2v __attribute__((ext_vector_type(2)));
                        u32x2v wa, wb; wa.x = cvt_pk_bf16(o1[0], o1[1]); wa.y = cvt_pk_bf16(o1[2], o1[3]); wb.x = cvt_pk_bf16(o2[0], o2[1]); wb.y = cvt_pk_bf16(o2[2], o2[3]);
                        *(u32x2v*)(rowp + bj * HALF) = wa; *(u32x2v*)(rowp + bj * HALF + 32) = wb; } }
        } else {
            const int col0 = gcol0 - (u.pn >= 24 ? 2048 : 0);
#pragma unroll
            for (int ai = 0; ai < 2; ++ai)
#pragma unroll
                for (int m = 0; m < 4; ++m) { bf16_t* rowp = O + (size_t)(row0 + ai * HALF + m * 16) * ldc + col0;
#pragma unroll
                    for (int bj = 0; bj < 2; ++bj) PG8_ST16(rowp + bj * HALF, pack8(acc[ai][bj][m][0] * rv[ai][m], acc[ai][bj][m][1] * rv[ai][m])); }
        }
    }
};
struct EpiGateZ {
    static constexpr bool PERM = true, AFTER_DRAIN = false, LV = false; static constexpr int NST = 16;
    static constexpr int ldc = 22528;
    unsigned char* O; const float* bias; const float* rs; float wsc;
    static __device__ __forceinline__ unsigned pk_u8x4(const f32x4 v) { unsigned w = 0u;
        w = __builtin_amdgcn_cvt_pk_u8_f32(fmaxf(__builtin_rintf(v[0] * 255.0f), 1.0f), 0u, w); w = __builtin_amdgcn_cvt_pk_u8_f32(fmaxf(__builtin_rintf(v[1] * 255.0f), 1.0f), 1u, w);
        w = __builtin_amdgcn_cvt_pk_u8_f32(fmaxf(__builtin_rintf(v[2] * 255.0f), 1.0f), 2u, w); w = __builtin_amdgcn_cvt_pk_u8_f32(fmaxf(__builtin_rintf(v[3] * 255.0f), 1.0f), 3u, w); return w; }
    __device__ __forceinline__ void operator()(const f32x4 (&acc)[2][2][4][2], const Unit& u, int wr_, int wc_, int, int) const {
        typedef unsigned u32x2v __attribute__((ext_vector_type(2)));
        int wr = wr_, wc = wc_; asm volatile("" : "+s"(wr), "+s"(wc));
        const int lane_ = mk_lane(), fr = lane_ & 15, fq = lane_ >> 4;
        const int row0 = u.pm * BM + wr * 64 + fr, col0 = u.pn * BM + wc * 32 + 8 * fq;
        f32x4 bv[2][2];
#pragma unroll
        for (int bj = 0; bj < 2; ++bj)
#pragma unroll
            for (int n = 0; n < 2; ++n) bv[bj][n] = *(const f32x4*)(bias + col0 + bj * HALF + 4 * n) * -1.4426950408889634f;
#pragma unroll
        for (int ai = 0; ai < 2; ++ai)
#pragma unroll
            for (int m = 0; m < 4; ++m) { const float r = rs[row0 + ai * HALF + m * 16] * (wsc * -1.4426950408889634f); unsigned char* rowp = O + (size_t)(row0 + ai * HALF + m * 16) * ldc + col0;
#pragma unroll
                for (int bj = 0; bj < 2; ++bj) { f32x4 v0 = acc[ai][bj][m][0] * r + bv[bj][0], v1 = acc[ai][bj][m][1] * r + bv[bj][1];
#pragma unroll
                    for (int e = 0; e < 4; ++e) { v0[e] = __builtin_amdgcn_rcpf(1.0f + __builtin_amdgcn_exp2f(v0[e])); v1[e] = __builtin_amdgcn_rcpf(1.0f + __builtin_amdgcn_exp2f(v1[e])); }
                    u32x2v w; w.x = pk_u8x4(v0); w.y = pk_u8x4(v1); *(u32x2v*)(rowp + bj * HALF) = w; } }
    }
};
template <int ACT> struct EpiBf16 {
    static constexpr bool PERM = true, AFTER_DRAIN = false, LV = (ACT == 0);     static constexpr int NST = 16;
    bf16_t* O; int ldc;
    __device__ __forceinline__ void operator()(const f32x4 (&acc)[2][2][4][2], const Unit& u, int wr, int wc, int fr, int fq) const {
        const int row0 = u.pm * BM + wr * 64 + fr, col0 = u.pn * BM + wc * 32 + 8 * fq;
#pragma unroll
        for (int ai = 0; ai < 2; ++ai)
#pragma unroll
            for (int m = 0; m < 4; ++m) { bf16_t* rowp = O + (size_t)(row0 + ai * HALF + m * 16) * ldc + col0;
#pragma unroll
                for (int bj = 0; bj < 2; ++bj) { f32x4 v0 = acc[ai][bj][m][0], v1 = acc[ai][bj][m][1];
                    if (ACT == 1) {
#pragma unroll
                        for (int e = 0; e < 4; ++e) { const float a = __builtin_amdgcn_fmed3f(v0[e], 0.f, __builtin_inff()), b = __builtin_amdgcn_fmed3f(v1[e], 0.f, __builtin_inff()); v0[e] = a * a; v1[e] = b * b; } }
                    PG8_ST16(rowp + bj * HALF, pack8(v0, v1)); } }
    }
};
template <int MODE> struct EpiGate {
    static constexpr bool PERM = true, AFTER_DRAIN = false, LV = false; static constexpr int NST = 16;
    static constexpr int ldc = 2048, ldg = 22528;
    bf16_t* O; const unsigned char* Zg; const bf16_t* P;
    __device__ __forceinline__ void operator()(const f32x4 (&acc)[2][2][4][2], const Unit& u, int wr, int wc, int fr, int fq) const {
        const int row0 = u.pm * BM + wr * 64 + fr, col0 = u.pn * BM + wc * 32 + 8 * fq;
#pragma unroll
        for (int ai = 0; ai < 2; ++ai)
#pragma unroll
            for (int m = 0; m < 4; ++m) { const size_t r = (size_t)(row0 + ai * HALF + m * 16);
#pragma unroll
                for (int bj = 0; bj < 2; ++bj) {
                    typedef unsigned u32x2v __attribute__((ext_vector_type(2)));
                    const u32x2v g = *(const u32x2v*)(Zg + r * ldg + col0 + bj * HALF); constexpr float q = 1.0f / 255.0f;
                    f32x4 v0 = acc[ai][bj][m][0] * ((f32x4){(float)(g.x & 255u), (float)((g.x >> 8) & 255u), (float)((g.x >> 16) & 255u), (float)(g.x >> 24)} * q);
                    f32x4 v1 = acc[ai][bj][m][1] * ((f32x4){(float)(g.y & 255u), (float)((g.y >> 8) & 255u), (float)((g.y >> 16) & 255u), (float)(g.y >> 24)} * q);
                    if (MODE == 1) { const u32x4 p = *(const u32x4*)(P + r * ldc + col0 + bj * HALF);
                        v0 += (f32x4){bf_lo(p.x), bf_hi(p.x), bf_lo(p.y), bf_hi(p.y)}; v1 += (f32x4){bf_lo(p.z), bf_hi(p.z), bf_lo(p.w), bf_hi(p.w)}; }
                    PG8_ST16(O + r * ldc + col0 + bj * HALF, pack8(v0, v1)); } }
    }
};
struct EpiGateDual {
    static constexpr bool PERM = true, AFTER_DRAIN = false, LV = false; static constexpr int NST = 16;
    static constexpr int ldc = 2048, ldg = 22528, gboff = 2048;
    bf16_t* O; const unsigned char* Zg;
#define EGD_U8(w) (f32x4){(float)((w) & 255u), (float)(((w) >> 8) & 255u), (float)(((w) >> 16) & 255u), (float)((w) >> 24)}
    __device__ __forceinline__ void mid(f32x4 (&acc)[2][2][4][2], const Unit& u, int wr, int wc, int fr, int fq) const {
        typedef unsigned u32x2v __attribute__((ext_vector_type(2)));
        const int row0 = u.pm * BM + wr * 64 + fr, col0 = u.pn * BM + wc * 32 + 8 * fq;
        u32x2v ga[2][4][2], gb[2][4][2];
#pragma unroll
        for (int ai = 0; ai < 2; ++ai)
#pragma unroll
            for (int m = 0; m < 4; ++m)
#pragma unroll
                for (int bj = 0; bj < 2; ++bj) { const unsigned char* gp = Zg + (size_t)(row0 + ai * HALF + m * 16) * ldg + col0 + bj * HALF;
                    ga[ai][m][bj] = *(const u32x2v*)gp; gb[ai][m][bj] = *(const u32x2v*)(gp + gboff); }
        __builtin_amdgcn_sched_barrier(0);
#pragma unroll
        for (int ai = 0; ai < 2; ++ai)
#pragma unroll
            for (int m = 0; m < 4; ++m)
#pragma unroll
                for (int bj = 0; bj < 2; ++bj) {
                    const f32x4 b0 = EGD_U8(gb[ai][m][bj].x), b1 = EGD_U8(gb[ai][m][bj].y);
                    const f32x4 r0 = {__builtin_amdgcn_rcpf(b0[0]), __builtin_amdgcn_rcpf(b0[1]), __builtin_amdgcn_rcpf(b0[2]), __builtin_amdgcn_rcpf(b0[3])}, r1 = {__builtin_amdgcn_rcpf(b1[0]), __builtin_amdgcn_rcpf(b1[1]), __builtin_amdgcn_rcpf(b1[2]), __builtin_amdgcn_rcpf(b1[3])};
                    acc[ai][bj][m][0] = acc[ai][bj][m][0] * (EGD_U8(ga[ai][m][bj].x) * r0); acc[ai][bj][m][1] = acc[ai][bj][m][1] * (EGD_U8(ga[ai][m][bj].y) * r1); }
    }
    __device__ __forceinline__ void operator()(const f32x4 (&acc)[2][2][4][2], const Unit& u, int wr, int wc, int fr, int fq) const {
        typedef unsigned u32x2v __attribute__((ext_vector_type(2)));
        const int row0 = u.pm * BM + wr * 64 + fr, col0 = u.pn * BM + wc * 32 + 8 * fq; constexpr float q = 1.0f / 255.0f;
        u32x2v gb[2][4][2];
#pragma unroll
        for (int ai = 0; ai < 2; ++ai)
#pragma unroll
            for (int m = 0; m < 4; ++m)
#pragma unroll
                for (int bj = 0; bj < 2; ++bj) gb[ai][m][bj] = *(const u32x2v*)(Zg + (size_t)(row0 + ai * HALF + m * 16) * ldg + gboff + col0 + bj * HALF);
        __builtin_amdgcn_sched_barrier(0);
#pragma unroll
        for (int ai = 0; ai < 2; ++ai)
#pragma unroll
            for (int m = 0; m < 4; ++m) { const size_t r = (size_t)(row0 + ai * HALF + m * 16);
#pragma unroll
                for (int bj = 0; bj < 2; ++bj) {
                    const f32x4 v0 = acc[ai][bj][m][0] * (EGD_U8(gb[ai][m][bj].x) * q), v1 = acc[ai][bj][m][1] * (EGD_U8(gb[ai][m][bj].y) * q);
                    PG8_ST16(O + r * ldc + col0 + bj * HALF, pack8(v0, v1)); } }
    }
#undef EGD_U8
};
struct EpiF32 {
    static constexpr bool PERM = false, AFTER_DRAIN = false, LV = false; static constexpr int NST = 32;
    float* O; int ldc;
    __device__ __forceinline__ void operator()(const f32x4 (&acc)[2][2][4][2], const Unit& u, int wr, int wc, int fr, int fq) const {
        const int row0 = u.pm * BM + wr * 64 + fr, col0 = u.pn * BM + wc * 32 + 4 * fq;
#pragma unroll
        for (int ai = 0; ai < 2; ++ai)
#pragma unroll
            for (int m = 0; m < 4; ++m) { float* rowp = O + (size_t)(row0 + ai * HALF + m * 16) * ldc + col0;
#pragma unroll
                for (int bj = 0; bj < 2; ++bj)
#pragma unroll
                    for (int n = 0; n < 2; ++n) *(f32x4*)(rowp + bj * HALF + n * 16) = acc[ai][bj][m][n]; }
    }
};

__device__ __forceinline__ void glds16_asm(const void* sbase  , unsigned voff, unsigned lds_dst) { unsigned keep;
    asm volatile("s_mov_b32 %0, m0\n\ts_mov_b32 m0, %3\n\ts_nop 0\n\tglobal_load_lds_dwordx4 %1, %2\n\ts_mov_b32 m0, %0" : "=&s"(keep) : "v"(voff), "s"(sbase), "s"(lds_dst) : "memory"); }
template <bool L> __device__ __forceinline__ unsigned pg8_lv(unsigned v) { if constexpr (L) asm volatile("" : "+v"(v)); return v; }
template <class Epi, class Sched, bool ALIGN_EPI = false, bool SP2 = false, bool FP8 = false>
__device__ __forceinline__ void gemm_phase(PG8_LAS unsigned char* lds, const Gemm g, const Sched& S, const Epi& E, const int wave_s) {
    int tid_ = wave_s * 64 + mk_lane(); asm volatile("" : "+v"(tid_));
    int wid_ = wave_s; asm volatile("" : "+s"(wid_));
    const int tid = tid_, wid = wid_, lane = tid & 63, wr = wid >> 2, wc = wid & 3, fr = lane & 15, fq = lane >> 4;
    const int KB = FP8 ? g.K : 2 * g.K, nt = KB / (2 * BK);
    unsigned voffA[2], voffB[2];
#pragma unroll
    for (int i = 0; i < 2; ++i) { int R, C; stage_rc(tid * 16 + i * 8192, R, C); const int Rb = Epi::PERM ? ((R & ~31) + perm32(R & 31)) : R;
        voffA[i] = (unsigned)(R * KB + C * 2); voffB[i] = (unsigned)(Rb * KB + C * 2); }
    const size_t kstep = (size_t)(BK * 2);
    const size_t hstep = (size_t)HALF * KB;
    const size_t tstep = 2 * hstep;
    const unsigned ldsw = (unsigned)wid * 1024u;
    const int aoff = lds_byte(wr * 64 + fr, fq * 8), boff = lds_byte(wc * 32 + fr, fq * 8);
#define PG8_SA(b, h) (((b) * 2 + (h)) * HTB)
#define PG8_SB(b, h) ((4 + (b) * 2 + (h)) * HTB)
#define PG8_STAGE(bufoff, gbase, voff) do { _Pragma("unroll") for (int _i = 0; _i < 2; ++_i) \
        __builtin_amdgcn_global_load_lds((const unsigned*)((const char*)(gbase) + pg8_lv<(FP8 || Epi::LV)>((voff)[_i])), (PG8_LAS unsigned*)(lds + (bufoff) + ldsw + _i * 8192), 16, 0, 0); } while (0)
#define PG8_LDA(dst, b, h) do { _Pragma("unroll") for (int m = 0; m < 4; ++m) _Pragma("unroll") for (int k = 0; k < 2; ++k) dst[m][k] = *(const PG8_LAS bf16x8*)(lds + PG8_SA(b, h) + aoff + m * 2048 + k * 1024); } while (0)
#define PG8_LDB(dst, b, h) do { _Pragma("unroll") for (int n = 0; n < 2; ++n) _Pragma("unroll") for (int k = 0; k < 2; ++k) dst[n][k] = *(const PG8_LAS bf16x8*)(lds + PG8_SB(b, h) + boff + n * 2048 + k * 1024); } while (0)
#define PG8_CAT(x0, x1) __builtin_bit_cast(v8i32, __builtin_shufflevector((x0), (x1), 0, 1, 2, 3, 4, 5, 6, 7, 8, 9, 10, 11, 12, 13, 14, 15))
#define PG8_MMA(ai, bj, At, Bt) do { __builtin_amdgcn_s_setprio(1); _Pragma("unroll") for (int m = 0; m < 4; ++m) _Pragma("unroll") for (int n = 0; n < 2; ++n) { \
        if constexpr (FP8) acc[ai][bj][m][n] = __builtin_amdgcn_mfma_scale_f32_16x16x128_f8f6f4(PG8_CAT(Bt[n][0], Bt[n][1]), PG8_CAT(At[m][0], At[m][1]), acc[ai][bj][m][n], 0, 0, 0, 0, 0, 0); \
        else { _Pragma("unroll") for (int k = 0; k < 2; ++k) acc[ai][bj][m][n] = __builtin_amdgcn_mfma_f32_16x16x32_bf16(Bt[n][k], At[m][k], acc[ai][bj][m][n], 0, 0, 0); } } __builtin_amdgcn_s_setprio(0); } while (0)
#if defined(PG8_SAFE_WAITS) && PG8_SAFE_WAITS
#define PG8_WAIT_V(n) asm volatile("s_waitcnt vmcnt(0)" ::: "memory")
#else
#define PG8_WAIT_V(n) asm volatile("s_waitcnt vmcnt(" #n ")" ::: "memory")
#endif
#define PG8_WAIT_L(n) asm volatile("s_waitcnt lgkmcnt(" #n ")" ::: "memory")
#if defined(PG8_SAFE_WAITS) && PG8_SAFE_WAITS
#define PG8_WAIT_VR(r) asm volatile("s_waitcnt vmcnt(0)" ::: "memory")
#else
#define PG8_WAIT_VR(r) do { if (r) { if constexpr (Epi::NST >= 16) asm volatile("s_waitcnt vmcnt(24)" ::: "memory"); else { static_assert(Epi::NST >= 8, "relaxed waits: at least 8 epilogue stores"); asm volatile("s_waitcnt vmcnt(16)" ::: "memory"); } } else asm volatile("s_waitcnt vmcnt(8)" ::: "memory"); } while (0)
#endif
#define PG8_BAR __builtin_amdgcn_s_barrier()
#define PG8_SCHED __builtin_amdgcn_sched_barrier(0)
    Unit cur, nxt; int ui = 0;
    if (!S.next(0, cur)) return;
    f32x4 acc[2][2][4][2];
#pragma unroll
    for (int a = 0; a < 2; ++a)
#pragma unroll
        for (int b = 0; b < 2; ++b)
#pragma unroll
            for (int m = 0; m < 4; ++m)
#pragma unroll
                for (int n = 0; n < 2; ++n) acc[a][b][m][n] = (f32x4){0.f, 0.f, 0.f, 0.f};
    bf16x8 At[4][2], B0[2][2], B1[2][2];
    const char* cA = (const char*)g.A + (size_t)cur.pm * tstep; const char* cB = (const char*)g.Bt + (size_t)cur.pn * tstep;
    S.a_ready(cur);
    if constexpr (SP2) {
        PG8_STAGE(PG8_SB(0, 0), cB, voffB); PG8_STAGE(PG8_SB(0, 1), cB + hstep, voffB); PG8_STAGE(PG8_SA(0, 0), cA, voffA); PG8_STAGE(PG8_SA(0, 1), cA + hstep, voffA);
        if (wr == 1) PG8_BAR;
        PG8_WAIT_V(2); PG8_BAR;
        PG8_STAGE(PG8_SB(1, 0), cB + kstep, voffB); PG8_STAGE(PG8_SA(1, 0), cA + kstep, voffA); PG8_STAGE(PG8_SB(1, 1), cB + hstep + kstep, voffB);
        PG8_WAIT_V(6); PG8_BAR;
    } else {
        PG8_STAGE(PG8_SB(0, 0), cB, voffB); PG8_STAGE(PG8_SA(0, 0), cA, voffA); PG8_STAGE(PG8_SB(0, 1), cB + hstep, voffB); PG8_STAGE(PG8_SA(0, 1), cA + hstep, voffA);
        if (wr == 1) PG8_BAR;
        PG8_WAIT_V(4); PG8_BAR;
        PG8_STAGE(PG8_SB(1, 0), cB + kstep, voffB); PG8_STAGE(PG8_SA(1, 0), cA + kstep, voffA); PG8_STAGE(PG8_SB(1, 1), cB + hstep + kstep, voffB);
        PG8_WAIT_V(6); PG8_BAR;
    }
    for (;;) {
        const int lt_ = mk_lane(), fr = lt_ & 15, fq = lt_ >> 4;
        unsigned voffA[2], voffB[2];
#pragma unroll
        for (int i = 0; i < 2; ++i) { int R, C; stage_rc((wid * 64 + lt_) * 16 + i * 8192, R, C); const int Rb = Epi::PERM ? ((R & ~31) + perm32(R & 31)) : R;
            voffA[i] = (unsigned)(R * KB + C * 2); voffB[i] = (unsigned)(Rb * KB + C * 2); }
        const int aoff = lds_byte(wr * 64 + fr, fq * 8), boff = lds_byte(wc * 32 + fr, fq * 8);
        const bool has_next = S.next(ui + 1, nxt);
        const char* nA = has_next ? (const char*)g.A + (size_t)nxt.pm * tstep : cA; const char* nB = has_next ? (const char*)g.Bt + (size_t)nxt.pn * tstep : cB;
#define PG8_PAIR_SP2(RLX, t) PG8_PAIR_SP2X(RLX, t, cA, cB, nA, nB)
          \
#define PG8_PAIR_SP2X(RLX, t, BA, BB, NXA, NXB) do { \
            const bool last = ((t) == nt - 2); \
            const char* a1 = (BA) + (size_t)((t) + 1) * kstep; \
            const char* a2 = last ? (NXA) : (BA) + (size_t)((t) + 2) * kstep; const char* b2 = last ? (NXB) : (BB) + (size_t)((t) + 2) * kstep; \
            const char* a3 = a2 + kstep; const char* b3 = b2 + kstep; \
            if (last && has_next) S.a_ready(nxt); \
            PG8_LDB(B0, 0, 0); PG8_LDB(B1, 0, 1); PG8_SCHED; PG8_LDA(At, 0, 0); if (!(RLX)) PG8_STAGE(PG8_SA(1, 1), a1 + hstep, voffA); \
            PG8_WAIT_VR(RLX); PG8_WAIT_L(0); PG8_BAR; PG8_MMA(0, 0, At, B0); PG8_MMA(0, 1, At, B1); PG8_BAR; PG8_SCHED; \
            PG8_LDA(At, 0, 1); PG8_STAGE(PG8_SB(0, 0), b2, voffB); PG8_STAGE(PG8_SB(0, 1), b2 + hstep, voffB); PG8_STAGE(PG8_SA(0, 0), a2, voffA); \
            PG8_WAIT_VR(RLX); PG8_WAIT_L(0); PG8_BAR; PG8_MMA(1, 0, At, B0); PG8_MMA(1, 1, At, B1); PG8_BAR; PG8_SCHED; \
            PG8_LDB(B0, 1, 0); PG8_LDB(B1, 1, 1); PG8_SCHED; PG8_LDA(At, 1, 0); PG8_STAGE(PG8_SA(0, 1), a2 + hstep, voffA); \
            PG8_WAIT_VR(RLX); PG8_WAIT_L(0); PG8_BAR; PG8_MMA(0, 0, At, B0); PG8_MMA(0, 1, At, B1); PG8_BAR; PG8_SCHED; \
            PG8_LDA(At, 1, 1); PG8_STAGE(PG8_SB(1, 0), b3, voffB); PG8_STAGE(PG8_SB(1, 1), b3 + hstep, voffB); PG8_STAGE(PG8_SA(1, 0), a3, voffA); \
            PG8_WAIT_V(8); PG8_WAIT_L(0); PG8_BAR; PG8_MMA(1, 0, At, B0); PG8_MMA(1, 1, At, B1); PG8_BAR; PG8_SCHED; } while (0)
        if constexpr (SP2) {
#if PG8_RELAX == 2
            for (int t = 0; t < nt; t += 2) { const bool rlx = (t == 0) && (ui > 0); PG8_PAIR_SP2(rlx, t); }
#else
            int t0 = 0;
            if constexpr (Sched::DUAL) {
                const char* cA2 = S.opA2() + (size_t)cur.pm * tstep; const char* cB2 = S.opB2() + (size_t)cur.pn * tstep;
                if constexpr (PG8_RELAX) { if (ui > 0) { PG8_PAIR_SP2X(1, 0, cA, cB, cA2, cB2); t0 = 2; } }
                for (int t = t0; t < nt; t += 2) PG8_PAIR_SP2X(0, t, cA, cB, cA2, cB2);
                {   Unit um = cur; asm volatile("" : "+s"(um.pm), "+s"(um.pn)); const int lm_ = mk_lane(); E.mid(acc, um, wr, wc, lm_ & 15, lm_ >> 4); }
                for (int t = 0; t < nt; t += 2) PG8_PAIR_SP2X(0, t, cA2, cB2, nA, nB);
            } else {
            if constexpr (PG8_RELAX) { if (ui > 0) { PG8_PAIR_SP2(1, 0); t0 = 2; } }
            for (int t = t0; t < nt; t += 2) PG8_PAIR_SP2(0, t);
            }
#endif
        } else {
        for (int t = 0; t < nt; t += 2) {
            const bool last = (t == nt - 2);
            const char* a1 = cA + (size_t)(t + 1) * kstep;
            const char* a2 = last ? nA : cA + (size_t)(t + 2) * kstep; const char* b2 = last ? nB : cB + (size_t)(t + 2) * kstep;
            const char* a3 = a2 + kstep; const char* b3 = b2 + kstep;
            if (last && has_next) S.a_ready(nxt);
            PG8_LDB(B0, 0, 0); PG8_SCHED; PG8_LDA(At, 0, 0); PG8_STAGE(PG8_SA(1, 1), a1 + hstep, voffA);
            PG8_WAIT_L(8); PG8_BAR; PG8_WAIT_L(0); PG8_MMA(0, 0, At, B0); PG8_BAR; PG8_SCHED;
            PG8_LDB(B1, 0, 1); PG8_STAGE(PG8_SB(0, 0), b2, voffB);
            PG8_BAR; PG8_WAIT_L(0); PG8_MMA(0, 1, At, B1); PG8_BAR;
            PG8_LDA(At, 0, 1); PG8_STAGE(PG8_SA(0, 0), a2, voffA);
            PG8_BAR; PG8_WAIT_L(0); PG8_MMA(1, 0, At, B0); PG8_BAR; PG8_SCHED;
            PG8_STAGE(PG8_SB(0, 1), b2 + hstep, voffB);
            PG8_WAIT_V(6); PG8_BAR; PG8_MMA(1, 1, At, B1); PG8_BAR;
            PG8_LDB(B0, 1, 0); PG8_SCHED; PG8_LDA(At, 1, 0); PG8_STAGE(PG8_SA(0, 1), a2 + hstep, voffA);
            PG8_WAIT_L(8); PG8_BAR; PG8_WAIT_L(0); PG8_MMA(0, 0, At, B0); PG8_BAR; PG8_SCHED;
            PG8_LDB(B1, 1, 1); PG8_STAGE(PG8_SB(1, 0), b3, voffB);
            PG8_BAR; PG8_WAIT_L(0); PG8_MMA(0, 1, At, B1); PG8_BAR;
            PG8_LDA(At, 1, 1); PG8_STAGE(PG8_SA(1, 0), a3, voffA);
            PG8_BAR; PG8_WAIT_L(0); PG8_MMA(1, 0, At, B0); PG8_BAR; PG8_SCHED;
            PG8_STAGE(PG8_SB(1, 1), b3 + hstep, voffB);
            PG8_WAIT_V(6); PG8_BAR; PG8_MMA(1, 1, At, B1); PG8_BAR;
        }
        }
#undef PG8_PAIR_SP2
#undef PG8_PAIR_SP2X
        if constexpr (ALIGN_EPI) { if (wr == 0) PG8_BAR; }
        if constexpr (SP2 && PG8_RELAX) { if (has_next) {
            const char* eb = nA + kstep + hstep;
#pragma unroll
            for (int i_ = 0; i_ < 2; ++i_) { unsigned vo_ = voffA[i_]; asm volatile("" : "+v"(vo_));
                glds16_asm(eb, vo_, (unsigned)__builtin_amdgcn_readfirstlane((int)(unsigned)(size_t)(lds + PG8_SA(1, 1)) + (int)ldsw + i_ * 8192)); }
            PG8_SCHED; } }
        if constexpr (!Epi::AFTER_DRAIN) { Unit ue = cur; asm volatile("" : "+s"(ue.pm), "+s"(ue.pn));
            const int le_ = mk_lane(); E(acc, ue, wr, wc, le_ & 15, le_ >> 4); S.done(cur); }
        if (!has_next) break;
#pragma unroll
        for (int a = 0; a < 2; ++a)
#pragma unroll
            for (int b = 0; b < 2; ++b)
#pragma unroll
                for (int m = 0; m < 4; ++m)
#pragma unroll
                    for (int n = 0; n < 2; ++n) acc[a][b][m][n] = (f32x4){0.f, 0.f, 0.f, 0.f};
        cur = nxt; cA = nA; cB = nB; ++ui;
        if constexpr (ALIGN_EPI) { if (wr == 1) PG8_BAR; }
    }
    PG8_WAIT_V(0);
    if constexpr (!ALIGN_EPI) { if (wr == 0) PG8_BAR; }
    PG8_BAR;
    if constexpr (Epi::AFTER_DRAIN) { E.fused(acc, cur, wr, wc, fr, fq, lds, wid, lane); S.done(cur); }
#undef PG8_SA
#undef PG8_SB
#undef PG8_STAGE
#undef PG8_LDA
#undef PG8_LDB
#undef PG8_MMA
#undef PG8_CAT
#undef PG8_WAIT_V
#undef PG8_WAIT_L
#undef PG8_WAIT_VR
#undef PG8_BAR
#undef PG8_SCHED
}
}

namespace att {
typedef unsigned short bf16_t;
using bf16x8 = __attribute__((ext_vector_type(8))) short;
using s16x4  = __attribute__((ext_vector_type(4))) short;
using f32x16 = __attribute__((ext_vector_type(16))) float;
using f32x4  = __attribute__((ext_vector_type(4))) float;
using u32x4  = __attribute__((ext_vector_type(4))) unsigned;
#define ATT_LAS __attribute__((address_space(3)))
constexpr int   D = 128, NW = 8, QBLK = 32, KVBLK = 64;
constexpr float SCALE = 0.088388347648318440f;
constexpr float THR = 8.f;
constexpr int SHM_V = KVBLK * D * 2, SHM_K = KVBLK * D * 2, SHM_ATTN = 2 * SHM_V + 2 * SHM_K + NW * 64 * 4;
#define KSWZ(row, colB) ((row) * 256 + ((colB) ^ (((row) & 7) << 4)))
#define SBAR() __builtin_amdgcn_sched_barrier(0)
__device__ __forceinline__ int crow(int r, int hi) { return (r & 3) + 8 * (r >> 2) + 4 * hi; }
typedef float f32x2_t __attribute__((ext_vector_type(2)));
typedef __bf16 bf16x2_t __attribute__((ext_vector_type(2)));
__device__ __forceinline__ unsigned cvtpk(float lo, float hi) { const f32x2_t v = {lo, hi}; const bf16x2_t b = __builtin_convertvector(v, bf16x2_t); return __builtin_bit_cast(unsigned, b); }

template <bool FIXED> __device__ __forceinline__ void partialSM(f32x16& p0, f32x16& p1, float& m_reg, float& mn, float& alpha, const float mCfix) {
  constexpr float C = SCALE * 1.4426950408889634f;
  if constexpr (FIXED) { alpha = 1.f; mn = 0.f; (void)mCfix;
#pragma unroll
    for (int r = 0; r < 16; ++r) p0[r] = __builtin_amdgcn_exp2f(p0[r]);
    return; }
  float pmax = p0[0];
#pragma unroll
  for (int r = 1; r < 16; ++r) pmax = fmaxf(pmax, p0[r]);
#pragma unroll
  for (int r = 0; r < 16; ++r) pmax = fmaxf(pmax, p1[r]);
  { auto rr = __builtin_amdgcn_permlane32_swap(__float_as_uint(pmax), __float_as_uint(pmax), false, false);
    pmax = fmaxf(__uint_as_float(rr[0]), __uint_as_float(rr[1])); }
  if (__builtin_expect(__all(pmax - m_reg <= THR / SCALE), 1)) { mn = m_reg; alpha = 1.f; }
  else { mn = fmaxf(m_reg, pmax); alpha = __builtin_amdgcn_exp2f((m_reg - mn) * C); m_reg = mn; }
  float mnC = -mn * C;
#pragma unroll
  for (int r = 0; r < 16; ++r) p0[r] = fmaf(p0[r], C, mnC);
#pragma unroll
  for (int r = 0; r < 16; ++r) p1[r] = fmaf(p1[r], C, mnC);
#pragma unroll
  for (int r = 0; r < 16; ++r) p0[r] = __builtin_amdgcn_exp2f(p0[r]);
}
__device__ __forceinline__ void finishSM(f32x16& p0, f32x16& p1, float alpha, float& l_reg, bf16x8& pa0, bf16x8& pa1, bf16x8& pa2, bf16x8& pa3) {
#pragma unroll
  for (int r = 0; r < 16; ++r) p1[r] = __builtin_amdgcn_exp2f(p1[r]);
  float ps = 0;
#pragma unroll
  for (int r = 0; r < 16; ++r) ps += p0[r];
#pragma unroll
  for (int r = 0; r < 16; ++r) ps += p1[r];
  { auto rr = __builtin_amdgcn_permlane32_swap(__float_as_uint(ps), __float_as_uint(ps), false, false);
    ps = __uint_as_float(rr[0]) + __uint_as_float(rr[1]); }
  l_reg = l_reg * alpha + ps;
#define PK4(P, BASE, OUT) do { unsigned a0 = cvtpk(P[BASE + 0], P[BASE + 1]), a1 = cvtpk(P[BASE + 2], P[BASE + 3]);   \
    unsigned b0 = cvtpk(P[BASE + 4], P[BASE + 5]), b1 = cvtpk(P[BASE + 6], P[BASE + 7]);                              \
    auto r0 = __builtin_amdgcn_permlane32_swap(a0, b0, false, false); auto r1 = __builtin_amdgcn_permlane32_swap(a1, b1, false, false); \
    u32x4 w = {r0[0], r1[0], r0[1], r1[1]}; OUT = __builtin_bit_cast(bf16x8, w); } while (0)
  PK4(p0, 0, pa0); PK4(p0, 8, pa1); PK4(p1, 0, pa2); PK4(p1, 8, pa3);
#undef PK4
}
template <bool FIXED> __device__ __forceinline__ void qkt(f32x16& p0, f32x16& p1, const ATT_LAS char* Ks, const bf16x8* qr, int r32, int hi, const f32x16& cinit) {
  if constexpr (!FIXED) { p0 = f32x16{}; p1 = f32x16{}; }
#pragma unroll
  for (int d0 = 0; d0 < 8; ++d0) { int cb = (d0 * 16 + hi * 8) * 2;
    bf16x8 b0 = *(const ATT_LAS bf16x8*)(Ks + KSWZ(r32, cb));
    bf16x8 b1 = *(const ATT_LAS bf16x8*)(Ks + KSWZ(32 + r32, cb));
    if (FIXED && d0 == 0) { p0 = __builtin_amdgcn_mfma_f32_32x32x16_bf16(b0, qr[d0], cinit, 0, 0, 0); p1 = __builtin_amdgcn_mfma_f32_32x32x16_bf16(b1, qr[d0], cinit, 0, 0, 0); }
    else { p0 = __builtin_amdgcn_mfma_f32_32x32x16_bf16(b0, qr[d0], p0, 0, 0, 0); p1 = __builtin_amdgcn_mfma_f32_32x32x16_bf16(b1, qr[d0], p1, 0, 0, 0); } }
}
__device__ __forceinline__ int v_st(int k, int c) { const int kk = (k & ~0xC) | ((k & 4) << 1) | ((k & 8) >> 1); return ((kk >> 3) * 4 + (c >> 5)) * 512 + ((kk & 7) * 32 + (c & 31)) * 2; }
__device__ __forceinline__ int v_rd_base(int lane) { return ((lane & 3) << 3) | (((lane >> 2) & 3) << 6) | (((lane >> 4) & 1) << 5) | (((lane >> 5) & 1) << 8); }
constexpr int v_rd_off(int d0, int ks, int half) { return d0 * 512 + ks * 4096 + half * 2048; }
template <int OFF> __device__ __forceinline__ s16x4 tr_read(int vb) {
  s16x4 r; asm volatile("ds_read_b64_tr_b16 %0, %1 offset:%2" : "=&v"(r) : "v"(vb), "i"(OFF) : "memory"); return r;
}
template <int D0> __device__ __forceinline__ void pv_one(f32x16& od, int vb, bf16x8 pa0, bf16x8 pa1, bf16x8 pa2, bf16x8 pa3) {
  const s16x4 l0 = tr_read<v_rd_off(D0, 0, 0)>(vb), h0 = tr_read<v_rd_off(D0, 0, 1)>(vb), l1 = tr_read<v_rd_off(D0, 1, 0)>(vb), h1 = tr_read<v_rd_off(D0, 1, 1)>(vb);
  const s16x4 l2 = tr_read<v_rd_off(D0, 2, 0)>(vb), h2 = tr_read<v_rd_off(D0, 2, 1)>(vb), l3 = tr_read<v_rd_off(D0, 3, 0)>(vb), h3 = tr_read<v_rd_off(D0, 3, 1)>(vb);
  asm volatile("s_waitcnt lgkmcnt(0)" ::: "memory"); SBAR();
#define PK(L, H) (bf16x8){L[0], L[1], L[2], L[3], H[0], H[1], H[2], H[3]}
  od = __builtin_amdgcn_mfma_f32_32x32x16_bf16(pa0, PK(l0, h0), od, 0, 0, 0);
  od = __builtin_amdgcn_mfma_f32_32x32x16_bf16(pa1, PK(l1, h1), od, 0, 0, 0);
  od = __builtin_amdgcn_mfma_f32_32x32x16_bf16(pa2, PK(l2, h2), od, 0, 0, 0);
  od = __builtin_amdgcn_mfma_f32_32x32x16_bf16(pa3, PK(l3, h3), od, 0, 0, 0);
#undef PK
}
__device__ __forceinline__ void pv_d0(f32x16* o, int vb, bf16x8 pa0, bf16x8 pa1, bf16x8 pa2, bf16x8 pa3) {
  pv_one<0>(o[0], vb, pa0, pa1, pa2, pa3); pv_one<1>(o[1], vb, pa0, pa1, pa2, pa3); pv_one<2>(o[2], vb, pa0, pa1, pa2, pa3); pv_one<3>(o[3], vb, pa0, pa1, pa2, pa3);
}
__device__ __forceinline__ float bflo(unsigned w) { return __uint_as_float(w << 16); }
__device__ __forceinline__ float bfhi(unsigned w) { return __uint_as_float(w & 0xffff0000u); }

template <int LDQ, int LDK, int LDO, bool FIXED>
__device__ __forceinline__ void attn_unit(const bf16_t* __restrict__ Qb, const bf16_t* __restrict__ Kh, const bf16_t* __restrict__ Vh, bf16_t* __restrict__ Ob,
                                          int t0, const float* __restrict__ qg, const float* __restrict__ rope, int seq, ATT_LAS char* lds, const int wave_s, const float mCfix) {
  int tid_ = wave_s * 64 + mk_lane(); asm volatile("" : "+v"(tid_));
  int wid_ = wave_s; asm volatile("" : "+s"(wid_));
  const int tid = tid_, wid = wid_, lane = tid & 63, r32 = lane & 31, hi = lane >> 5;
  ATT_LAS char* V_lds = lds; ATT_LAS char* K_lds = lds + 2 * SHM_V;
  ATT_LAS float* ws = (ATT_LAS float*)(lds + 2 * SHM_V + 2 * SHM_K) + wid * 64; ATT_LAS float* li_l = ws; ATT_LAS float* al_l = ws + 32;
  float m_reg = -1e30f, l_reg = 0; f32x16 o[4] = {}; bf16x8 qr[8];
  f32x16 cinit;
#pragma unroll
  for (int r = 0; r < 16; ++r) cinit[r] = FIXED ? mCfix : 0.f;
  {
    const bf16_t* Qw = Qb + (size_t)(wid * QBLK + r32) * LDQ + hi * 8;
#pragma unroll
    for (int d0 = 0; d0 < 8; ++d0) qr[d0] = *(const bf16x8*)(Qw + d0 * 16);
    (void)qg; (void)rope; (void)t0;
  }
  const int sr = tid >> 4, sc = (tid & 15) * 8, vst0 = v_st(sr, sc), vst1 = v_st(32 + sr, sc);
  const int vb0 = (int)(unsigned)(size_t)V_lds + v_rd_base(lane);
  struct { bf16x8 vs0, vs1, ks0, ks1; } sr_[2];
#define SLOAD(i, k0) do { sr_[i].vs0 = *(const bf16x8*)(Vh + (size_t)((k0) + sr) * LDK + sc); sr_[i].vs1 = *(const bf16x8*)(Vh + (size_t)((k0) + 32 + sr) * LDK + sc); \
    sr_[i].ks0 = *(const bf16x8*)(Kh + (size_t)((k0) + sr) * LDK + sc); sr_[i].ks1 = *(const bf16x8*)(Kh + (size_t)((k0) + 32 + sr) * LDK + sc); } while (0)
#define SWRITE(b, i) do { *(ATT_LAS bf16x8*)(V_lds + (b) * SHM_V + vst0) = sr_[i].vs0;          \
    *(ATT_LAS bf16x8*)(V_lds + (b) * SHM_V + vst1) = sr_[i].vs1; const int kc = sc * 2;               \
    *(ATT_LAS bf16x8*)(K_lds + (b) * SHM_K + KSWZ(sr, kc)) = sr_[i].ks0;                       \
    *(ATT_LAS bf16x8*)(K_lds + (b) * SHM_K + KSWZ(32 + sr, kc)) = sr_[i].ks1; } while (0)
#define SWAIT() asm volatile("s_waitcnt vmcnt(4)" ::: "memory")
#define RESC(a) do { if constexpr (!FIXED) if (__any((a) < 1.f)) { if (hi == 0) al_l[r32] = (a); asm volatile("s_waitcnt lgkmcnt(0)" ::: "memory"); \
    _Pragma("unroll") for (int d = 0; d < 4; ++d) _Pragma("unroll") for (int r = 0; r < 16; ++r) o[d][r] *= al_l[crow(r, hi)]; } } while (0)
  f32x16 pA0, pA1, pB0, pB1; float mnA, mnB, alA, alB; bf16x8 pa0, pa1, pa2, pa3; const int NT = seq / KVBLK;
  constexpr int SE = 0, SO = 1;
  SLOAD(SE, 0); asm volatile("s_waitcnt vmcnt(0)" ::: "memory"); SWRITE(0, SE); __syncthreads();
  qkt<FIXED>(pA0, pA1, K_lds, qr, r32, hi, cinit); partialSM<FIXED>(pA0, pA1, m_reg, mnA, alA, mCfix);
  SLOAD(SO, KVBLK); if (2 < NT) SLOAD(SE, 2 * KVBLK);
  SWAIT(); SWRITE(1, SO); __syncthreads();
  for (int j = 1; j + 1 < NT; j += 2) {
    SBAR(); qkt<FIXED>(pB0, pB1, K_lds + SHM_K, qr, r32, hi, cinit);
    finishSM(pA0, pA1, alA, l_reg, pa0, pa1, pa2, pa3); SBAR();
    SLOAD(SO, (j + 2) * KVBLK); SBAR();
    pv_d0(o, vb0, pa0, pa1, pa2, pa3); partialSM<FIXED>(pB0, pB1, m_reg, mnB, alB, mCfix);
    __syncthreads(); SWAIT(); SWRITE(0, SE);
    RESC(alB); __syncthreads();
    SBAR(); qkt<FIXED>(pA0, pA1, K_lds, qr, r32, hi, cinit);
    finishSM(pB0, pB1, alB, l_reg, pa0, pa1, pa2, pa3); SBAR();
    if (j + 3 < NT) SLOAD(SE, (j + 3) * KVBLK); SBAR();
    pv_d0(o, vb0 + SHM_V, pa0, pa1, pa2, pa3); partialSM<FIXED>(pA0, pA1, m_reg, mnA, alA, mCfix);
    __syncthreads(); SWAIT(); SWRITE(1, SO);
    RESC(alA); __syncthreads();
  }
  SBAR(); qkt<FIXED>(pB0, pB1, K_lds + SHM_K, qr, r32, hi, cinit);
  finishSM(pA0, pA1, alA, l_reg, pa0, pa1, pa2, pa3); SBAR();
  pv_d0(o, vb0, pa0, pa1, pa2, pa3); partialSM<FIXED>(pB0, pB1, m_reg, mnB, alB, mCfix);
  __syncthreads(); RESC(alB);
  finishSM(pB0, pB1, alB, l_reg, pa0, pa1, pa2, pa3); SBAR();
  pv_d0(o, vb0 + SHM_V, pa0, pa1, pa2, pa3);
  if (hi == 0) li_l[r32] = l_reg; asm volatile("s_waitcnt lgkmcnt(0)" ::: "memory");
  float rli[16];
#pragma unroll
  for (int r = 0; r < 16; ++r) rli[r] = __builtin_amdgcn_rcpf(li_l[crow(r, hi)]);
  bf16_t* Ow = Ob + (size_t)(wid * QBLK) * LDO;
#pragma unroll
  for (int r = 0; r < 16; ++r) { const int orow = crow(r, hi);
#pragma unroll
    for (int d0 = 0; d0 < 4; ++d0) { const float v = o[d0][r] * rli[r]; Ow[(size_t)orow * LDO + d0 * 32 + r32] = (bf16_t)(cvtpk(v, v) & 0xffffu); } }
#undef SLOAD
#undef SWRITE
#undef SWAIT
#undef RESC
}
}

#ifndef WGM_BIG
#define WGM_BIG 8
#endif
#ifndef WGM_SQ
#define WGM_SQ 4
#endif
#ifndef MK_PER_PHASE
#define MK_PER_PHASE 0
#endif
#ifndef PG8_SP2
#define PG8_SP2 true
#endif
#ifndef PG8_ALIGN
#define PG8_ALIGN true
#endif
constexpr int NWAVES = 8;
constexpr int BATCH = 4, SEQ = 4096, DM = 2048, DEPTH = 4, HD = 128, NQH = 16, NKVH = 4, DFF = 8192, INW = 13312;
constexpr int M = BATCH * SEQ;
constexpr int ZW = 11264;
constexpr int Z_CB = 0, Z_U = 2048, Z_Q = 4096, Z_K = 6144, Z_V = 6656, Z_GA = 7168, Z_GB = 9216;
constexpr int G_GATE0 = 9216;
constexpr float RMS_EPS = 1e-6f;
constexpr size_t MiB = 1u << 20;
constexpr size_t WS_CTL = 0, CTL_ZERO_BYTES = 1 * MiB;
constexpr size_t WS_ROPE = 1 * MiB;
constexpr size_t WS_RS = WS_ROPE + 256 * 1024;
constexpr size_t WS_W = 2 * MiB, W_LAYER = 140 * MiB;
constexpr size_t W_IN = 0, W_OC = 52 * MiB, W_OA = 60 * MiB, W_MG = 68 * MiB, W_UP = 76 * MiB, W_DN = 108 * MiB;
constexpr size_t WS_H = WS_W + DEPTH * W_LAYER;
constexpr size_t W_G8 = 36 * MiB;
constexpr int N_MAIN = 9216, N_GATE = 4096;
constexpr float G8_SCALE = 64.f;
constexpr size_t WS_Z = WS_H + 64 * MiB;
constexpr size_t WS_CA = WS_Z + 416 * MiB;
constexpr size_t WS_O = WS_CA + 64 * MiB;
constexpr size_t WS_P = WS_O + 64 * MiB;
constexpr size_t WS_G = WS_P + 64 * MiB;
constexpr size_t WS_F = WS_G + 64 * MiB;
constexpr size_t WS_X = WS_F + 64 * MiB;
constexpr size_t WS_END = WS_F + 128 * MiB;
static_assert((size_t)INW * DM * 2 <= 52 * MiB && (size_t)M * ZW * 2 <= 416 * MiB && (size_t)M * DFF * 2 <= 416 * MiB, "d_ws map");
constexpr int CW_BAR = 4096;
constexpr int RING_BYTES = 131072, LDSCTL_OFF = RING_BYTES, MISC_OFF = LDSCTL_OFF + 320, LDS_BYTES = 147456;

#define GAS __attribute__((address_space(1)))
#define LAS __attribute__((address_space(3)))
typedef unsigned short bf16;
typedef unsigned v4u __attribute__((ext_vector_type(4)));
typedef unsigned v2u __attribute__((ext_vector_type(2)));
typedef float f32x4 __attribute__((ext_vector_type(4)));
typedef GAS unsigned gu32;
#define LDS_WAIT() asm volatile("s_waitcnt lgkmcnt(0)" ::: "memory")
__device__ __forceinline__ unsigned f2bf(float f) { unsigned u = __builtin_bit_cast(unsigned, f); return (u + 0x7fffu + ((u >> 16) & 1u)) >> 16; }
typedef float f32x2_t __attribute__((ext_vector_type(2)));
typedef __bf16 bf16x2_t __attribute__((ext_vector_type(2)));
__device__ __forceinline__ unsigned pk2(float lo, float hi) { const f32x2_t v = {lo, hi}; const bf16x2_t b = __builtin_convertvector(v, bf16x2_t); return __builtin_bit_cast(unsigned, b); }
__device__ __forceinline__ unsigned pk_fp8x4(float a, float b, float c, float d) { int w = __builtin_amdgcn_cvt_pk_fp8_f32(a, b, 0, false); w = __builtin_amdgcn_cvt_pk_fp8_f32(c, d, w, true); return (unsigned)w; }
__device__ __forceinline__ float bflo(unsigned w) { return __uint_as_float(w << 16); }
__device__ __forceinline__ float bfhi(unsigned w) { return __uint_as_float(w & 0xffff0000u); }

#define XB_TMO      128
#define XB_XCNT(j)  (256  + 64 * (j))
#define XB_XSUB(j)  (1280 + 64 * (j))
#define XB_XGEN(j)  (2304 + 64 * (j))
#define XB_TOP      3328
#define XB_TOPGEN   3392
#define XCD_BAR_WORDS 3456
#define XB_SPIN_CAP (1u << 18)

__device__ __forceinline__ unsigned xb_ld(unsigned* p)              { return __hip_atomic_load(p, __ATOMIC_RELAXED, __HIP_MEMORY_SCOPE_AGENT); }
__device__ __forceinline__ unsigned xb_add(unsigned* p, unsigned v) { return __hip_atomic_fetch_add(p, v, __ATOMIC_RELAXED, __HIP_MEMORY_SCOPE_AGENT); }
__device__ __forceinline__ unsigned xb_xcc_id() { return (unsigned)__builtin_amdgcn_s_getreg((3 << 11) | 20) & 0xFu; }
#define XB_SPIN(cond, bar) do { unsigned _sp = 0; while (cond) { __builtin_amdgcn_s_sleep(1); \
    if ((++_sp & 255u) == 0u) { if (xb_ld(&(bar)[XB_TMO])) break; if (_sp > XB_SPIN_CAP) { atomicAdd(&(bar)[XB_TMO], 1u); break; } } } } while (0)

struct XcdBarrier {
    unsigned* bar; unsigned x;
    volatile LAS unsigned* st;
};

__device__ __forceinline__ XcdBarrier xcd_barrier_post(unsigned* bar, volatile LAS unsigned* st, const bool t0  ) {
    XcdBarrier b; b.bar = bar; b.x = xb_xcc_id(); b.st = st;
    if (t0) (void)xb_add(&bar[XB_XCNT(b.x)], 1u);
    return b;
}
__device__ __forceinline__ void xcd_barrier_complete(unsigned* bar, unsigned x, unsigned& nloc, unsigned& nx) {
    const unsigned G = gridDim.x * gridDim.y * gridDim.z;
    unsigned sum, cnt, mine, sp = 0u;
    for (;;) {
        sum = 0u; cnt = 0u; mine = 0u;
#pragma unroll
        for (unsigned j = 0; j < 16; ++j) { const unsigned c = xb_ld(&bar[XB_XCNT(j)]); sum += c; cnt += (c > 0u) ? 1u : 0u; mine = (j == x) ? c : mine; }
        if (sum == G) break;
        __builtin_amdgcn_s_sleep(1);
        if ((++sp & 255u) == 0u) { if (xb_ld(&bar[XB_TMO])) break; if (sp > XB_SPIN_CAP) { atomicAdd(&bar[XB_TMO], 1u); break; } }
    }
    nloc = mine > 0u ? mine : 1u; nx = cnt > 0u ? cnt : 1u;
}

__device__ __forceinline__ void xcd_barrier(const XcdBarrier& b, const bool t0  ) {
    asm volatile("s_waitcnt vmcnt(0)" ::: "memory");
    __syncthreads();
    if (t0) {
        unsigned* bar = b.bar;
        __builtin_amdgcn_s_waitcnt(0);
        unsigned nloc = b.st[0], nx = b.st[1];
        if (nloc == 0u) { xcd_barrier_complete(bar, b.x, nloc, nx); b.st[0] = nloc; b.st[1] = nx; }
        const unsigned old = xb_add(&bar[XB_XSUB(b.x)], 1u);
        const unsigned gen = old / nloc;
        if (old + 1u == (gen + 1u) * nloc) {
            __builtin_amdgcn_fence(__ATOMIC_RELEASE, "agent");
            asm volatile("s_waitcnt vmcnt(0)" ::: "memory");
            const unsigned og = xb_add(&bar[XB_TOP], 1u);
            const unsigned tg = og / nx;
            if (og + 1u == (tg + 1u) * nx) xb_add(&bar[XB_TOPGEN], 1u);
            else XB_SPIN(xb_ld(&bar[XB_TOPGEN]) == tg, bar);
            __builtin_amdgcn_fence(__ATOMIC_ACQUIRE, "agent");
            xb_add(&bar[XB_XGEN(b.x)], 1u);
            asm volatile("s_waitcnt vmcnt(0)" ::: "memory");
        } else {
            XB_SPIN(xb_ld(&bar[XB_XGEN(b.x)]) == gen, bar);
            __builtin_amdgcn_fence(__ATOMIC_ACQUIRE, "agent");
            asm volatile("s_waitcnt vmcnt(0)" ::: "memory");
        }
    }
    __syncthreads();
}


__device__ __forceinline__ float wave_sum(float v, int lane) {
#pragma unroll
    for (int o = 1; o < 64; o <<= 1) v += mk_shfl_xor(v, o, lane);
    return v;
}
__device__ __forceinline__ void sincos_d(double a, float& c_out, float& s_out) {
    const double TWO_PI = 6.283185307179586476925287;
    const double k = __builtin_rint(a / TWO_PI); double r = a - k * TWO_PI; r *= 0.25;
    const double r2 = r * r;
    double s = r * (1.0 + r2 * (-1.0 / 6 + r2 * (1.0 / 120 + r2 * (-1.0 / 5040 + r2 * (1.0 / 362880 + r2 * (-1.0 / 39916800 + r2 * (1.0 / 6227020800.0)))))));
    double c = 1.0 + r2 * (-0.5 + r2 * (1.0 / 24 + r2 * (-1.0 / 720 + r2 * (1.0 / 40320 + r2 * (-1.0 / 3628800 + r2 * (1.0 / 479001600.0 + r2 * (-1.0 / 87178291200.0)))))));
#pragma unroll
    for (int i = 0; i < 2; ++i) { const double s2 = 2.0 * s * c, c2 = c * c - s * s; s = s2; c = c2; }
    c_out = (float)c; s_out = (float)s;
}
__device__ __forceinline__ void row_to_bf16_rs(const float* xrow, bf16* orow, unsigned char* o8row, float* rs, int lane) {
    const GAS f32x4* xr = (const GAS f32x4*)xrow + lane;
    f32x4 v[8]; float s = 0.f;
#pragma unroll
    for (int j = 0; j < 8; ++j) { v[j] = xr[64 * j]; s += (v[j].x * v[j].x + v[j].y * v[j].y) + (v[j].z * v[j].z + v[j].w * v[j].w); }
    const float rstd = __builtin_amdgcn_rsqf(wave_sum(s, lane) * (1.f / DM) + RMS_EPS);
    GAS v2u* o8 = (GAS v2u*)orow + lane;
#pragma unroll
    for (int j = 0; j < 8; ++j) { v2u w; w.x = pk2(v[j].x, v[j].y); w.y = pk2(v[j].z, v[j].w); o8[64 * j] = w; ((GAS unsigned*)o8row + lane)[64 * j] = pk_fp8x4(v[j].x, v[j].y, v[j].z, v[j].w); }
    if (lane == 0) *rs = rstd;
}

__device__ __forceinline__ void norm_res_rows(bf16* Xb, unsigned char* X8, float* out_f32, const bf16* Fb, float* rs, const float* gpost, const bool deferred, const bool write_rs, const bool poison, const int gw, const int NGW, const int lane) {
    f32x4 gp[8];
#pragma unroll
    for (int j = 0; j < 8; ++j) gp[j] = *((const GAS f32x4*)gpost + lane + 64 * j);
    for (int m = gw; m < M; m += NGW) {
        const GAS v2u* fr = (const GAS v2u*)(Fb + (size_t)m * DM) + lane; GAS v2u* xb = (GAS v2u*)(Xb + (size_t)m * DM) + lane;
        f32x4 fv[8], xv[8]; float s = 0.f;
        float epsr = RMS_EPS;
        if (deferred) { const float r = *(const GAS float*)(rs + m); const float t = __builtin_amdgcn_rcpf(r * r); epsr = RMS_EPS * t * t; }
#pragma unroll
        for (int j = 0; j < 8; ++j) { const v2u xw = xb[64 * j]; xv[j] = (f32x4){bflo(xw.x), bfhi(xw.x), bflo(xw.y), bfhi(xw.y)}; }
#pragma unroll
        for (int j = 0; j < 8; ++j) { const v2u fw = fr[64 * j]; fv[j] = (f32x4){bflo(fw.x), bfhi(fw.x), bflo(fw.y), bfhi(fw.y)}; s += (fv[j].x * fv[j].x + fv[j].y * fv[j].y) + (fv[j].z * fv[j].z + fv[j].w * fv[j].w); }
        const float rf = __builtin_amdgcn_rsqf(wave_sum(s, lane) * (1.f / DM) + epsr);
        float s2 = 0.f;
#pragma unroll
        for (int j = 0; j < 8; ++j) { xv[j] = xv[j] + fv[j] * rf * gp[j]; s2 += (xv[j].x * xv[j].x + xv[j].y * xv[j].y) + (xv[j].z * xv[j].z + xv[j].w * xv[j].w); }
        if (out_f32) { GAS f32x4* xo = (GAS f32x4*)(out_f32 + (size_t)m * DM) + lane; const float qn = __builtin_nanf("");
#pragma unroll
            for (int j = 0; j < 8; ++j) xo[64 * j] = poison ? (f32x4){qn, qn, qn, qn} : xv[j]; }
        else {
#pragma unroll
            for (int j = 0; j < 8; ++j) { v2u w; w.x = pk2(xv[j].x, xv[j].y); w.y = pk2(xv[j].z, xv[j].w); xb[64 * j] = w; }
            if (X8) { GAS unsigned* x8 = (GAS unsigned*)(X8 + (size_t)m * DM) + lane;
#pragma unroll
                for (int j = 0; j < 8; ++j) x8[64 * j] = pk_fp8x4(xv[j].x, xv[j].y, xv[j].z, xv[j].w); } }
        if (write_rs) {
            const float rx = __builtin_amdgcn_rsqf(wave_sum(s2, lane) * (1.f / DM) + RMS_EPS);
            if (lane == 0) *(GAS float*)(rs + m) = rx;
        }
    }
}

struct Args { const float* in[15]; float* out; unsigned char* ws; int ph_lo, ph_hi; };
typedef const __attribute__((address_space(4))) Args* kargs_t;
__device__ __forceinline__ kargs_t kargs_() { kargs_t p = (kargs_t)__builtin_amdgcn_kernarg_segment_ptr(); asm volatile("" : "+s"(p)); return p; }
__device__ __forceinline__ int ltid_(int wave_s) { int t = wave_s * 64 + mk_lane(); asm volatile("" : "+v"(t)); return t; }
#define IN_F(k) ((const float*)(const GAS float*)ka->in[k])
#define PHASE_VARS() const kargs_t ka = kargs_(); unsigned char* ws = (unsigned char*)(GAS unsigned char*)ka->ws; int wave_ = wave_s; asm volatile("" : "+s"(wave_)); const int tid = ltid_(wave_s), lane = tid & 63, wave = wave_; \
    const int G = gridDim.x, bx = blockIdx.x, vcu = (G % 8 == 0) ? (bx % 8) * (G / 8) + bx / 8 : bx, gw = vcu * NWAVES + wave, NGW = G * NWAVES; (void)ws; (void)lane; (void)gw; (void)NGW; (void)ka

constexpr int CW_I_IN = (DM / 64) * (INW / 32), CW_I_SQ = (DM / 64) * (DM / 32), CW_I_UP = (DM / 64) * (DFF / 32), CW_I_DN = (DFF / 64) * (DM / 32), CW_I_LAYER = CW_I_IN + 3 * CW_I_SQ + CW_I_UP + CW_I_DN;
__device__ __forceinline__ void convert_weights(const kargs_t ka, unsigned char* ws, LAS float* scr, const int it_first, const int it_end, const int NGW, const int lane) {
    constexpr int I_IN = CW_I_IN, I_SQ = CW_I_SQ, I_UP = CW_I_UP, I_LAYER = CW_I_LAYER;
#define CW_DECODE(it_, src_, dst_, K_, N_, gs_, gf_, f8_) do { const int l_ = (it_) / I_LAYER; int r_ = (it_) % I_LAYER; unsigned char* wl_ = ws + WS_W + (size_t)l_ * W_LAYER; const float* W_; bf16* WT_; gs_ = IN_F(1) + (size_t)l_ * DM; gf_ = false; \
        if (r_ < I_IN) { W_ = IN_F(2) + (size_t)l_ * DM * INW; WT_ = (bf16*)(wl_ + W_IN); K_ = DM; N_ = INW; gf_ = true; } \
        else if ((r_ -= I_IN) < I_SQ) { W_ = IN_F(7) + (size_t)l_ * DM * DM; WT_ = (bf16*)(wl_ + W_OC); K_ = DM; N_ = DM; } \
        else if ((r_ -= I_SQ) < I_SQ) { W_ = IN_F(8) + (size_t)l_ * DM * DM; WT_ = (bf16*)(wl_ + W_OA); K_ = DM; N_ = DM; } \
        else if ((r_ -= I_SQ) < I_SQ) { W_ = IN_F(9) + (size_t)l_ * DM * DM; WT_ = (bf16*)(wl_ + W_MG); K_ = DM; N_ = DM; } \
        else if ((r_ -= I_SQ) < I_UP) { W_ = IN_F(12) + (size_t)l_ * DM * DFF; WT_ = (bf16*)(wl_ + W_UP); K_ = DM; N_ = DFF; gs_ = IN_F(11) + (size_t)l_ * DM; gf_ = true; } \
        else { r_ -= I_UP; W_ = IN_F(13) + (size_t)l_ * DFF * DM; WT_ = (bf16*)(wl_ + W_DN); K_ = DFF; N_ = DM; } \
        const int nblk_ = N_ / 32, k0_ = 64 * (r_ / nblk_), n0_ = 32 * (r_ % nblk_); int ns_ = n0_;     \
        if (N_ == INW && n0_ >= 2048 && n0_ < 6144) { const int q_ = n0_ - 2048, t_ = q_ >> 8, rr_ = q_ & 255; ns_ = ((rr_ >> 7) ? 4096 : 2048) + 128 * t_ + (rr_ & 127); } \
        const bool pf_ = (N_ == INW && n0_ >= 6144 && n0_ < 8704);     \
        if (pf_) { const int wc_ = (n0_ >> 5) & 3; ns_ = (n0_ & ~127) + 64 * (wc_ >> 1) + 16 * (wc_ & 1); } \
        const int q4_ = lane & 7, co_ = pf_ ? (32 * (q4_ & 1) + 4 * (q4_ >> 1)) : 4 * q4_; \
        gs_ += (k0_ % DM) + 8 * (lane & 7);     \
        f8_ = (N_ == INW && n0_ >= N_MAIN);     \
        src_ = W_ + (size_t)(k0_ + (lane >> 3)) * N_ + ns_ + co_; dst_ = (f8_) ? (bf16*)(wl_ + W_G8 + (size_t)(n0_ - N_MAIN) * K_ + k0_) : WT_ + (size_t)n0_ * K_ + k0_; } while (0)
#define CW_LOAD(S, idx_) do { S##ok = (idx_) < it_end; S##i = S##ok ? (idx_) : it_first; const float* s_; const float* gs_; bf16* d_; int K_, N_; bool gf_, f8_; CW_DECODE(S##i, s_, d_, K_, N_, gs_, gf_, f8_); (void)d_; (void)K_; \
        { const f32x4 a_ = *(const GAS f32x4*)(gs_), b_ = *((const GAS f32x4*)(gs_) + 1); const f32x4 one_ = {1.f, 1.f, 1.f, 1.f}; S##g[0] = gf_ ? a_ : one_; S##g[1] = gf_ ? b_ : one_; if (f8_) { S##g[0] *= G8_SCALE; S##g[1] *= G8_SCALE; } } \
        _Pragma("unroll") for (int j_ = 0; j_ < 8; ++j_) S##v[j_] = *(const GAS f32x4*)(s_ + (size_t)(8 * j_) * N_); } while (0)
#define CW_PROCESS(S) do { const float* s_; const float* gs_; bf16* S##d; int S##K, N_; bool gf_, S##f8; { int ix_ = S##i; asm volatile("" : "+s"(ix_)); CW_DECODE(ix_, s_, S##d, S##K, N_, gs_, gf_, S##f8); } (void)s_; (void)gs_; (void)N_; (void)gf_;     \
        { const int rw_ = (lane >> 3) * 33 + 4 * (lane & 7); \
            _Pragma("unroll") for (int j_ = 0; j_ < 8; ++j_) { scr[rw_ + j_ * 8 * 33 + 0] = S##v[j_].x; scr[rw_ + j_ * 8 * 33 + 1] = S##v[j_].y; scr[rw_ + j_ * 8 * 33 + 2] = S##v[j_].z; scr[rw_ + j_ * 8 * 33 + 3] = S##v[j_].w; } } \
        LDS_WAIT(); asm volatile("" ::: "memory"); const int c_ = lane & 7; \
        _Pragma("unroll") for (int j_ = 0; j_ < 4; ++j_) { const int n_ = (lane >> 3) + 8 * j_; const LAS float* sp_ = scr + (8 * c_) * 33 + n_; \
            const float e0_ = sp_[0 * 33] * S##g[0].x, e1_ = sp_[1 * 33] * S##g[0].y, e2_ = sp_[2 * 33] * S##g[0].z, e3_ = sp_[3 * 33] * S##g[0].w, e4_ = sp_[4 * 33] * S##g[1].x, e5_ = sp_[5 * 33] * S##g[1].y, e6_ = sp_[6 * 33] * S##g[1].z, e7_ = sp_[7 * 33] * S##g[1].w; \
            if (S##f8) { v2u o8_; o8_.x = pk_fp8x4(e0_, e1_, e2_, e3_); o8_.y = pk_fp8x4(e4_, e5_, e6_, e7_); *(GAS v2u*)((unsigned char*)(S##d) + (size_t)n_ * (S##K) + 8 * c_) = o8_; } \
            else { v4u o_; o_.x = pk2(e0_, e1_); o_.y = pk2(e2_, e3_); o_.z = pk2(e4_, e5_); o_.w = pk2(e6_, e7_); *(GAS v4u*)((S##d) + (size_t)n_ * (S##K) + 8 * c_) = o_; } } \
        LDS_WAIT(); asm volatile("" ::: "memory"); } while (0)
#define CW_SET(S) f32x4 S##v[8], S##g[2]; int S##i = 0; bool S##ok = false
    CW_SET(a); CW_SET(b); CW_SET(c);
    int it = it_first;
    CW_LOAD(a, it); CW_LOAD(b, it + NGW);
    for (;;) {
        CW_LOAD(c, it + 2 * NGW); if (!aok) break; CW_PROCESS(a);
        CW_LOAD(a, it + 3 * NGW); if (!bok) break; CW_PROCESS(b);
        CW_LOAD(b, it + 4 * NGW); if (!cok) break; CW_PROCESS(c);
        it += 3 * NGW;
    }
#undef CW_SET
#undef CW_PROCESS
#undef CW_LOAD
#undef CW_DECODE
}

__global__ void __launch_bounds__(NWAVES * 64, 2) fwd_kernel(Args args) {
    extern __shared__ __attribute__((aligned(16))) unsigned char lds_raw[];
    LAS unsigned char* lds = (LAS unsigned char*)lds_raw;
    const int wave_s = __builtin_amdgcn_readfirstlane((int)threadIdx.x >> 6);
    {   PHASE_VARS();
        volatile LAS unsigned* MISC = (volatile LAS unsigned*)(lds + MISC_OFF);
        for (int u = tid; u < (LDS_BYTES - LDSCTL_OFF) / 4; u += NWAVES * 64) ((LAS unsigned*)(lds + LDSCTL_OFF))[u] = 0u;
        __syncthreads();
        (void)xcd_barrier_post((unsigned*)(ws + WS_CTL) + CW_BAR, MISC + 8, tid == 0);
    }
#define GRID_BAR() do { XcdBarrier b_; b_.bar = (unsigned*)((unsigned char*)(GAS unsigned char*)kargs_()->ws + WS_CTL) + CW_BAR; unsigned x_ = xb_xcc_id(); asm volatile("" : "+s"(x_)); b_.x = x_; \
    b_.st = (volatile LAS unsigned*)(lds + MISC_OFF) + 8; xcd_barrier(b_, ltid_(wave_s) == 0); } while (0)

#if MK_PER_PHASE
    const int ph_lo = kargs_()->ph_lo, ph_hi = kargs_()->ph_hi;
#define IN(k) (ph_lo <= (k) && (k) < ph_hi)
#else
#define IN(k) true
#endif
#define SEAM(k) do { if (IN(k) && IN((k) + 1)) GRID_BAR(); } while (0)
    if (IN(0)) {   PHASE_VARS();
        convert_weights(ka, ws, (LAS float*)(lds + wave * 16384), gw, CW_I_LAYER, NGW, lane);
        {
            float* rope = (float*)(ws + WS_ROPE);
            const int gid = vcu * (NWAVES * 64) + tid;
            if (gid < 64 * 32) { const int pos = gid >> 5, f = gid & 31;
                double w = 1.0; const double c0 = 0.74989420933245582730218;
                for (int i = 0; i < f; ++i) w *= c0;
                const float wf = (float)w; const float ang = (float)pos * wf;
                float c, s; sincos_d((double)ang, c, s);
                rope[2 * gid] = c; rope[2 * gid + 1] = s; }
        }
        {   const float* x_in = IN_F(0); bf16* Xb = (bf16*)(ws + WS_X); float* rs = (float*)(ws + WS_RS);
            for (int m = gw; m < M; m += NGW) row_to_bf16_rs(x_in + (size_t)m * DM, Xb + (size_t)m * DM, ws + WS_H + (size_t)m * DM, rs + m, lane);
        }
    }
    SEAM(0);

    for (int l = 0; l < DEPTH; ++l) {
        const int pb = 1 + 9 * l;
        if (IN(pb + 0)) {   PHASE_VARS(); unsigned char* wl = ws + WS_W + (size_t)l * W_LAYER;
            pg8::Gemm g{(const bf16*)(ws + WS_X), (const bf16*)(wl + W_IN), M, N_MAIN, DM}; pg8::StaticOrder S; S.init(M, N_MAIN, G, bx, WGM_BIG);
            float m0;
            {   const float* qg_ = IN_F(5) + (size_t)l * HD; const float* kg_ = IN_F(6) + (size_t)l * HD;
                float gq_ = fmaxf(fabsf(qg_[lane]), fabsf(qg_[lane + 64])), gk_ = fmaxf(fabsf(kg_[lane]), fabsf(kg_[lane + 64]));
#pragma unroll
                for (int o_ = 1; o_ < 64; o_ <<= 1) { gq_ = fmaxf(gq_, mk_shfl_xor(gq_, o_, lane)); gk_ = fmaxf(gk_, mk_shfl_xor(gk_, o_, lane)); }
                m0 = __uint_as_float((unsigned)__builtin_amdgcn_readfirstlane((int)__float_as_uint(11.313708499f * gq_ * gk_))); }
            pg8::EpiZ E{(bf16*)(ws + WS_Z), ZW, (const float*)(ws + WS_RS), IN_F(5) + (size_t)l * HD, IN_F(6) + (size_t)l * HD, (const float*)(ws + WS_ROPE),
                        (m0 <= 40.f) ? att::SCALE * 1.4426950408889634f : 1.0f, RMS_EPS, lds + MISC_OFF + 64};
            pg8::gemm_phase<pg8::EpiZ, pg8::StaticOrder, PG8_ALIGN, PG8_SP2>(lds, g, S, E, wave_s);
            {   pg8::Gemm g8{(const bf16*)(ws + WS_H), (const bf16*)(wl + W_G8), M, N_GATE, DM}; pg8::StaticOrder S8; S8.init(M, N_GATE, G, bx, WGM_BIG);
                static_assert(ZW * 2 == 22528 && DM == 2048, "pitches hard-coded in EpiGateZ / EpiGate");
            pg8::EpiGateZ E8{ws + WS_Z + (size_t)Z_GA * 2, IN_F(3) + (size_t)l * 2 * DM, (const float*)(ws + WS_RS), 1.0f / G8_SCALE};
                pg8::gemm_phase<pg8::EpiGateZ, pg8::StaticOrder, PG8_ALIGN, PG8_SP2, true>(lds, g8, S8, E8, wave_s);
            }
        }
        SEAM(pb + 0);
        if (IN(pb + 2)) {   PHASE_VARS();
            bf16* Zb = (bf16*)(ws + WS_Z); bf16* Ob = (bf16*)(ws + WS_O);
            const int nunits = BATCH * NQH * (SEQ / 256), per = (nunits + G - 1) / G;
            float m0;
            {   const float* qg_ = IN_F(5) + (size_t)l * HD; const float* kg_ = IN_F(6) + (size_t)l * HD;
                float gq_ = fmaxf(fabsf(qg_[lane]), fabsf(qg_[lane + 64])), gk_ = fmaxf(fabsf(kg_[lane]), fabsf(kg_[lane + 64]));
#pragma unroll
                for (int o_ = 1; o_ < 64; o_ <<= 1) { gq_ = fmaxf(gq_, mk_shfl_xor(gq_, o_, lane)); gk_ = fmaxf(gk_, mk_shfl_xor(gk_, o_, lane)); }
                m0 = __uint_as_float((unsigned)__builtin_amdgcn_readfirstlane((int)__float_as_uint(11.313708499f * gq_ * gk_))); }
            const bool fixed_ok = (m0 <= 40.f); const float mCfix = -m0 * 1.4426950408889634f;
            for (int i = 0; i < per; ++i) {
                const int u = (G == 256) ? ((vcu >> 5) * 128 + (i >> 1) * 64 + (vcu & 31) * 2 + (i & 1)) : (vcu * per + i);
                if (u >= nunits) break;
                const int bk = u >> 6, b = bk >> 2, kvh = bk & 3, r = u & 63, gq = r >> 4, qb = r & 15, h = kvh * 4 + gq;
                const bf16* Qb = Zb + (size_t)(b * SEQ + qb * 256) * ZW + Z_Q + h * HD;
                const bf16* Kh = Zb + (size_t)(b * SEQ) * ZW + Z_K + kvh * HD;
                const bf16* Vh = Zb + (size_t)(b * SEQ) * ZW + Z_V + kvh * HD;
                bf16* Oo = Ob + (size_t)(b * SEQ + qb * 256) * DM + h * HD;
                if (fixed_ok) att::attn_unit<ZW, ZW, DM, true>(Qb, Kh, Vh, Oo, qb * 256, IN_F(5) + (size_t)l * HD, (const float*)(ws + WS_ROPE), SEQ, (LAS char*)lds, wave_s, mCfix);
                else          att::attn_unit<ZW, ZW, DM, false>(Qb, Kh, Vh, Oo, qb * 256, IN_F(5) + (size_t)l * HD, (const float*)(ws + WS_ROPE), SEQ, (LAS char*)lds, wave_s, 0.f);
                if (l + 1 < DEPTH && i == ((vcu >> 3) % per)) {
                    __syncthreads();
                    const int wv_ = __builtin_amdgcn_readfirstlane(ltid_(wave_s) >> 6);
                    convert_weights(ka, ws, (LAS float*)(lds + wv_ * 16384), (l + 1) * CW_I_LAYER + gw, (l + 2) * CW_I_LAYER, NGW, ltid_(wave_s) & 63);
                    __syncthreads();
                }
            }
            bf16* CAb = (bf16*)(ws + WS_CA);
            {
            const float* cw = IN_F(4) + (size_t)l * 3 * DM;
            const int half = tid >> 8, c0 = (tid & 255) * 8;
            float w0[8], w1[8], w2[8];
#pragma unroll
            for (int e = 0; e < 8; ++e) { w0[e] = cw[c0 + e]; w1[e] = cw[DM + c0 + e]; w2[e] = cw[2 * DM + c0 + e]; }
            for (int unit = vcu; unit < M / 64; unit += G) {
                const int r0 = unit * 64 + half * 32;
                const bf16* zc = Zb + (size_t)r0 * ZW + c0;
                float up[8], uc[8], un[8];
                {   const bool hp = (r0 % SEQ) != 0;
                    const v4u a = *(const GAS v4u*)(zc + Z_U - (hp ? ZW : 0));
                    const float sc = hp ? 1.f : 0.f;
                    up[0] = bflo(a.x) * sc; up[1] = bfhi(a.x) * sc; up[2] = bflo(a.y) * sc; up[3] = bfhi(a.y) * sc; up[4] = bflo(a.z) * sc; up[5] = bfhi(a.z) * sc; up[6] = bflo(a.w) * sc; up[7] = bfhi(a.w) * sc; }
                {   const v4u a = *(const GAS v4u*)(zc + Z_U);
                    uc[0] = bflo(a.x); uc[1] = bfhi(a.x); uc[2] = bflo(a.y); uc[3] = bfhi(a.y); uc[4] = bflo(a.z); uc[5] = bfhi(a.z); uc[6] = bflo(a.w); uc[7] = bfhi(a.w); }
#pragma unroll 4
                for (int i = 0; i < 32; ++i) {
                    const int r = r0 + i; const bool hn = ((r + 1) % SEQ) != 0;
                    const bf16* zr = zc + (size_t)i * ZW;
                    const v4u a = *(const GAS v4u*)(zr + Z_U + (hn ? ZW : 0)), cb = *(const GAS v4u*)(zr + Z_CB);
                    const float sc = hn ? 1.f : 0.f;
                    un[0] = bflo(a.x) * sc; un[1] = bfhi(a.x) * sc; un[2] = bflo(a.y) * sc; un[3] = bfhi(a.y) * sc; un[4] = bflo(a.z) * sc; un[5] = bfhi(a.z) * sc; un[6] = bflo(a.w) * sc; un[7] = bfhi(a.w) * sc;
                    const float cbf[8] = {bflo(cb.x), bfhi(cb.x), bflo(cb.y), bfhi(cb.y), bflo(cb.z), bfhi(cb.z), bflo(cb.w), bfhi(cb.w)};
                    float o[8];
#pragma unroll
                    for (int e = 0; e < 8; ++e) { o[e] = cbf[e] * (w0[e] * up[e] + w1[e] * uc[e] + w2[e] * un[e]); up[e] = uc[e]; uc[e] = un[e]; }
                    v4u w; w.x = pk2(o[0], o[1]); w.y = pk2(o[2], o[3]); w.z = pk2(o[4], o[5]); w.w = pk2(o[6], o[7]);
                    *(GAS v4u*)(CAb + (size_t)r * DM + c0) = w;
                }
            }
            }
            __syncthreads();
        }
        SEAM(pb + 2);
        if (IN(pb + 3)) {   PHASE_VARS(); unsigned char* wl = ws + WS_W + (size_t)l * W_LAYER;
            pg8::Gemm g{(const bf16*)(ws + WS_CA), (const bf16*)(wl + W_OC), M, DM, DM}; pg8::DualOrder S; S.init(M, DM, G, bx, WGM_SQ); S.A2 = (const bf16*)(ws + WS_O); S.Bt2 = (const bf16*)(wl + W_OA);
            pg8::EpiGateDual E{(bf16*)(ws + WS_G), ws + WS_Z + (size_t)Z_GA * 2};
            pg8::gemm_phase<pg8::EpiGateDual, pg8::DualOrder, PG8_ALIGN, PG8_SP2>(lds, g, S, E, wave_s);
        }
        SEAM(pb + 3);
        if (IN(pb + 4)) {   PHASE_VARS(); unsigned char* wl = ws + WS_W + (size_t)l * W_LAYER;
            pg8::Gemm g{(const bf16*)(ws + WS_G), (const bf16*)(wl + W_MG), M, DM, DM}; pg8::StaticOrder S; S.init(M, DM, G, bx, WGM_SQ);
            pg8::EpiBf16<0> E{(bf16*)(ws + WS_F), DM};
            pg8::gemm_phase<pg8::EpiBf16<0>, pg8::StaticOrder, PG8_ALIGN, PG8_SP2>(lds, g, S, E, wave_s);
        }
        SEAM(pb + 4);
        if (IN(pb + 5)) {   PHASE_VARS();
            norm_res_rows((bf16*)(ws + WS_X), nullptr, nullptr, (const bf16*)(ws + WS_F), (float*)(ws + WS_RS), IN_F(10) + (size_t)l * DM, false, true, false, gw, NGW, lane);
        }
        SEAM(pb + 5);
        if (IN(pb + 6)) {   PHASE_VARS(); unsigned char* wl = ws + WS_W + (size_t)l * W_LAYER;
            pg8::Gemm g{(const bf16*)(ws + WS_X), (const bf16*)(wl + W_UP), M, DFF, DM}; pg8::StaticOrder S; S.init(M, DFF, G, bx, WGM_BIG);
            pg8::EpiBf16<1> E{(bf16*)(ws + WS_Z), DFF};
            pg8::gemm_phase<pg8::EpiBf16<1>, pg8::StaticOrder, PG8_ALIGN, PG8_SP2>(lds, g, S, E, wave_s);
        }
        SEAM(pb + 6);
        if (IN(pb + 7)) {   PHASE_VARS(); unsigned char* wl = ws + WS_W + (size_t)l * W_LAYER;
            pg8::Gemm g{(const bf16*)(ws + WS_Z), (const bf16*)(wl + W_DN), M, DM, DFF}; pg8::StaticOrder S; S.init(M, DM, G, bx, 4);
            pg8::EpiBf16<0> E{(bf16*)(ws + WS_F), DM};
            pg8::gemm_phase<pg8::EpiBf16<0>, pg8::StaticOrder, PG8_ALIGN, PG8_SP2>(lds, g, S, E, wave_s);
        }
        SEAM(pb + 7);
        if (IN(pb + 8)) {   PHASE_VARS();
            const bool more = (l + 1 < DEPTH);
            const bool poison = !more && (__hip_atomic_load((unsigned*)(ws + WS_CTL) + CW_BAR + XB_TMO, __ATOMIC_RELAXED, __HIP_MEMORY_SCOPE_AGENT) != 0u);
            norm_res_rows((bf16*)(ws + WS_X), more ? ws + WS_H : nullptr, more ? nullptr : (float*)(GAS float*)ka->out, (const bf16*)(ws + WS_F), (float*)(ws + WS_RS), IN_F(14) + (size_t)l * DM, true, more, poison, gw, NGW, lane);
        }
        if (l + 1 < DEPTH) SEAM(pb + 8);
    }
}


extern "C" void kernel_launch(void* const* d_in, const int* in_sizes, int n_in, void* d_out, int out_size, void* d_ws, size_t ws_size, hipStream_t stream) {
    static int grid = 0;
    if (grid == 0) {
        if (n_in != 15 || in_sizes[0] != M * DM || out_size != M * DM || ws_size < WS_END) {
            fprintf(stderr, "kernel_launch: built for 15 inputs, x/out of %d floats, >= %zu bytes of workspace; got n_in %d, in0 %d, out %d, ws %zu; nothing launched\n", M * DM, (size_t)WS_END, n_in, n_in > 0 ? in_sizes[0] : -1, out_size, ws_size);
            grid = -1; return; }
        int dev = 0, cus = 0, per_cu = 0;
        if (hipGetDevice(&dev) != hipSuccess || hipDeviceGetAttribute(&cus, hipDeviceAttributeMultiprocessorCount, dev) != hipSuccess) { fprintf(stderr, "kernel_launch: device query failed\n"); grid = -1; return; }
        if (hipFuncSetAttribute((const void*)fwd_kernel, hipFuncAttributeMaxDynamicSharedMemorySize, LDS_BYTES) != hipSuccess) { fprintf(stderr, "kernel_launch: hipFuncSetAttribute failed\n"); grid = -1; return; }
        if (hipOccupancyMaxActiveBlocksPerMultiprocessor(&per_cu, (const void*)fwd_kernel, NWAVES * 64, LDS_BYTES) != hipSuccess || per_cu < 1)
            fprintf(stderr, "kernel_launch: note: occupancy query reports %d workgroups per CU\n", per_cu);
        (void)hipGetLastError();
        grid = cus;
    }
    if (grid < 0) return;
    if (hipMemsetAsync((char*)d_ws + WS_CTL, 0, CTL_ZERO_BYTES, stream) != hipSuccess) { fprintf(stderr, "kernel_launch: hipMemsetAsync failed\n"); return; }
    Args a{};
    for (int i = 0; i < 15; ++i) a.in[i] = (const float*)d_in[i];
    a.out = (float*)d_out; a.ws = (unsigned char*)d_ws;
    constexpr int NPHASES = 1 + 9 * DEPTH;
    if (MK_PER_PHASE) { for (int p = 0; p < NPHASES; ++p) { a.ph_lo = p; a.ph_hi = p + 1; hipLaunchKernelGGL(fwd_kernel, dim3(grid), dim3(NWAVES * 64), LDS_BYTES, stream, a); } }
    else { a.ph_lo = 0; a.ph_hi = NPHASES; hipLaunchKernelGGL(fwd_kernel, dim3(grid), dim3(NWAVES * 64), LDS_BYTES, stream, a); }
    const hipError_t le = hipPeekAtLastError();
    if (le != hipSuccess) fprintf(stderr, "kernel_launch: launch failed: %s\n", hipGetErrorName(le));
}
```

```cpp
#include <hip/hip_runtime.h>
#include <cstdio>
#include <cstdint>

__device__ __forceinline__ int mk_lane() { int l; asm volatile("v_mbcnt_lo_u32_b32 %0, -1, 0\n\tv_mbcnt_hi_u32_b32 %0, -1, %0" : "=v"(l)); return l; }
__device__ __forceinline__ float mk_shfl_xor(float v, int mask, int lane) { return __builtin_bit_cast(float, __builtin_amdgcn_ds_bpermute((lane ^ mask) << 2, __builtin_bit_cast(int, v))); }
#ifndef PG8_RELAX
#define PG8_RELAX 1
#endif
namespace pg8 {
#define PG8_LAS __attribute__((address_space(3)))
typedef unsigned short bf16_t;
typedef short bf16x8 __attribute__((ext_vector_type(8)));
typedef float f32x4 __attribute__((ext_vector_type(4)));
typedef unsigned u32x4 __attribute__((ext_vector_type(4)));
typedef int v8i32 __attribute__((ext_vector_type(8)));
constexpr int BM = 256, BK = 64, HALF = 128, HTB = HALF * BK * 2  , STAGE_BYTES = 8 * HTB, NXCD = 8, WGM = 8;

__host__ __device__ __forceinline__ int lds_byte(int r, int c) { const int st = (r >> 4) * 2 + (c >> 5), rr = r & 15, cc = c & 31, ob = rr * 64 + cc * 2; return st * 1024 + (ob ^ (((ob >> 9) & 1) << 5)); }
__host__ __device__ __forceinline__ void stage_rc(int b, int& R, int& C) { const int st = b / 1024, sb = b % 1024, swz = sb ^ (((sb >> 9) & 1) << 5); R = (st >> 1) * 16 + swz / 64; C = (st & 1) * 32 + (swz % 64) / 2; }
__host__ __device__ __forceinline__ int perm32(int rho) { const int n = rho >> 4, i = rho & 15; return 8 * (i >> 2) + 4 * n + (i & 3); }

struct Unit { int pm, pn; };
struct Gemm { const bf16_t* A; const bf16_t* Bt; int M, N, K; };

struct StaticOrder {
    int nM, nN, nwg, G, c, wgm;
    __host__ __device__ void init(int M, int N, int G_, int c_, int wgm_ = WGM) { nM = M / BM; nN = N / BM; nwg = nM * nN; G = G_; c = c_; wgm = wgm_; }
    __host__ __device__ bool next(int i, Unit& u) const {
        const long L = (long)i * G + c; if (L >= nwg) return false;
        int wgid = (int)L; { const int q = nwg / NXCD, r = nwg % NXCD, xcd = wgid % NXCD, off = wgid / NXCD; wgid = (xcd < r ? xcd * (q + 1) : r * (q + 1) + (xcd - r) * q) + off; }
        const int nig = wgm * nN, gid = wgid / nig, fm = gid * wgm, gsz = (nM - fm) < wgm ? (nM - fm) : wgm;
        u.pm = fm + ((wgid % nig) % gsz); u.pn = (wgid % nig) / gsz; return true;
    }
    static constexpr bool DUAL = false;
    __device__ __forceinline__ const char* opA2() const { return nullptr; }
    __device__ __forceinline__ const char* opB2() const { return nullptr; }
    __device__ __forceinline__ void a_ready(const Unit&) const {}
    __device__ __forceinline__ void done(const Unit&) const {}
};
struct DualOrder : StaticOrder {
    const bf16_t* A2; const bf16_t* Bt2;
    static constexpr bool DUAL = true;
    __device__ __forceinline__ const char* opA2() const { return (const char*)A2; }
    __device__ __forceinline__ const char* opB2() const { return (const char*)Bt2; }
};


#ifndef PG8_NT_STORES
#define PG8_NT_STORES 0
#endif
#if PG8_NT_STORES
#define PG8_ST16(p, v) __builtin_nontemporal_store((v), (u32x4*)(p))
#else
#define PG8_ST16(p, v) (*(u32x4*)(p) = (v))
#endif
typedef float f32x2_t __attribute__((ext_vector_type(2)));
typedef __bf16 bf16x2_t __attribute__((ext_vector_type(2)));
__device__ __forceinline__ unsigned cvt_pk_bf16(float lo, float hi) { const f32x2_t v = {lo, hi}; const bf16x2_t b = __builtin_convertvector(v, bf16x2_t); return __builtin_bit_cast(unsigned, b); }
__device__ __forceinline__ float bf_lo(unsigned w) { return __uint_as_float(w << 16); }
__device__ __forceinline__ float bf_hi(unsigned w) { return __uint_as_float(w & 0xffff0000u); }
__device__ __forceinline__ float sigmoid_f(float x) { return __builtin_amdgcn_rcpf(1.0f + __builtin_amdgcn_exp2f(-1.4426950408889634f * x)); }
__device__ __forceinline__ u32x4 pack8(const f32x4 v0, const f32x4 v1) { u32x4 w; w.x = cvt_pk_bf16(v0[0], v0[1]); w.y = cvt_pk_bf16(v0[2], v0[3]); w.z = cvt_pk_bf16(v1[0], v1[1]); w.w = cvt_pk_bf16(v1[2], v1[3]); return w; }

struct EpiZ {
    static constexpr bool PERM = true, AFTER_DRAIN = false, LV = false; static constexpr int NST = 8;
    bf16_t* O; int ldc; const float* rs; const float* qg; const float* kg; const float* rope; float qscale; float eps; PG8_LAS unsigned char* misc;
    __device__ __forceinline__ void operator()(const f32x4 (&acc)[2][2][4][2], const Unit& u, int wr_, int wc_, int, int) const {
        int wr = wr_, wc = wc_; asm volatile("" : "+s"(wr), "+s"(wc));
        const int lane_ = mk_lane(), fr = lane_ & 15, fq = lane_ >> 4;
        const int row0 = u.pm * BM + wr * 64 + fr, gcol0 = u.pn * BM + wc * 32 + 8 * fq;
        float rv[2][4];
#pragma unroll
        for (int ai = 0; ai < 2; ++ai)
#pragma unroll
            for (int m = 0; m < 4; ++m) rv[ai][m] = rs[row0 + ai * HALF + m * 16];
        if (u.pn >= 8 && u.pn < 24) {
            const int col0 = 2048 + HALF * (u.pn - 8) + wc * 32 + 8 * fq;
#pragma unroll
            for (int ai = 0; ai < 2; ++ai)
#pragma unroll
                for (int m = 0; m < 4; ++m) { const float r2 = rv[ai][m] * rv[ai][m]; PG8_ST16(O + (size_t)(row0 + ai * HALF + m * 16) * ldc + col0, pack8(acc[ai][0][m][0] * acc[ai][1][m][0] * r2, acc[ai][0][m][1] * acc[ai][1][m][1] * r2)); }
        } else if (u.pn >= 24 && u.pn < 34) {
            const bool isq = u.pn < 32; const float* gn = isq ? qg : kg;
            const int ax = wc >> 1, f0 = 16 * (wc & 1) + 4 * fq, d1 = 64 * ax + f0;
            const f32x4 g1 = *(const f32x4*)(gn + d1), g2 = *(const f32x4*)(gn + d1 + 32);
            PG8_LAS float* PARTf = (PG8_LAS float*)misc; const PG8_LAS f32x4* PART4 = (const PG8_LAS f32x4*)misc;
#pragma unroll
            for (int ai = 0; ai < 2; ++ai)
#pragma unroll
                for (int bj = 0; bj < 2; ++bj) { float sq[4];
#pragma unroll
                    for (int m = 0; m < 4; ++m) { const f32x4 v0 = acc[ai][bj][m][0], v1 = acc[ai][bj][m][1]; sq[m] = ((v0[0] * v0[0] + v0[1] * v0[1]) + (v0[2] * v0[2] + v0[3] * v0[3])) + ((v1[0] * v1[0] + v1[1] * v1[1]) + (v1[2] * v1[2] + v1[3] * v1[3])); }
                    auto r02 = __builtin_amdgcn_permlane32_swap(__float_as_uint(sq[0]), __float_as_uint(sq[2]), false, false); const float w0 = __uint_as_float(r02[0]) + __uint_as_float(r02[1]);
                    auto r13 = __builtin_amdgcn_permlane32_swap(__float_as_uint(sq[1]), __float_as_uint(sq[3]), false, false); const float w1 = __uint_as_float(r13[0]) + __uint_as_float(r13[1]);
                    auto rr = __builtin_amdgcn_permlane16_swap(__float_as_uint(w0), __float_as_uint(w1), false, false); const float tw = __uint_as_float(rr[0]) + __uint_as_float(rr[1]);
                    PARTf[((((wr * 2 + ai) * 2 + bj) * 64) + (fq * 16 + fr)) * 4 + wc] = tw; }
            asm volatile("s_waitcnt lgkmcnt(0)" ::: "memory"); __builtin_amdgcn_s_barrier(); asm volatile("" ::: "memory");
            const int colh = u.pn * BM - 2048 + d1;
#pragma unroll
            for (int ai = 0; ai < 2; ++ai)
#pragma unroll
                for (int m = 0; m < 4; ++m) { const int row = row0 + ai * HALF + m * 16, t = row & 4095, pos = ax ? (t & 63) : (t >> 6);
                    const f32x4 csa = *(const f32x4*)(rope + (size_t)(pos * 32 + f0) * 2), csb = *(const f32x4*)(rope + (size_t)(pos * 32 + f0) * 2 + 4);
                    const f32x4 cc = {csa[0], csa[2], csb[0], csb[2]}, sn = {csa[1], csa[3], csb[1], csb[3]};
                    const float r = rv[ai][m]; const float epsr = eps * __builtin_amdgcn_rcpf(r * r);
                    bf16_t* rowp = O + (size_t)row * ldc + colh;
#pragma unroll
                    for (int bj = 0; bj < 2; ++bj) { const f32x4 pp = PART4[((wr * 2 + ai) * 2 + bj) * 64 + m * 16 + fr];
                        const float rstd = __builtin_amdgcn_rsqf(((pp[0] + pp[1]) + (pp[2] + pp[3])) * (1.0f / 128.0f) + epsr) * (isq ? qscale : 1.0f);
                        const f32x4 x1 = acc[ai][bj][m][0] * g1 * rstd, x2 = acc[ai][bj][m][1] * g2 * rstd;
                        const f32x4 o1 = x1 * cc - x2 * sn, o2 = x2 * cc + x1 * sn;
                        typedef unsigned u32x2v __attribute__((ext_vector_type(2)));
                        u32x2v wa, wb; wa.x = cvt_pk_bf16(o1[0], o1[1]); wa.y = cvt_pk_bf16(o1[2], o1[3]); wb.x = cvt_pk_bf16(o2[0], o2[1]); wb.y = cvt_pk_bf16(o2[2], o2[3]);
                        *(u32x2v*)(rowp + bj * HALF) = wa; *(u32x2v*)(rowp + bj * HALF + 32) = wb; } }
        } else {
            const int col0 = gcol0 - (u.pn >= 24 ? 2048 : 0);
#pragma unroll
            for (int ai = 0; ai < 2; ++ai)
#pragma unroll
                for (int m = 0; m < 4; ++m) { bf16_t* rowp = O + (size_t)(row0 + ai * HALF + m * 16) * ldc + col0;
#pragma unroll
                    for (int bj = 0; bj < 2; ++bj) PG8_ST16(rowp + bj * HALF, pack8(acc[ai][bj][m][0] * rv[ai][m], acc[ai][bj][m][1] * rv[ai][m])); }
        }
    }
};
struct EpiGateZ {
    static constexpr bool PERM = true, AFTER_DRAIN = false, LV = false; static constexpr int NST = 16;
    static constexpr int ldc = 22528;
    unsigned char* O; const float* bias; const float* rs; float wsc;
    static __device__ __forceinline__ unsigned pk_u8x4(const f32x4 v) { unsigned w = 0u;
        w = __builtin_amdgcn_cvt_pk_u8_f32(fmaxf(__builtin_rintf(v[0] * 255.0f), 1.0f), 0u, w); w = __builtin_amdgcn_cvt_pk_u8_f32(fmaxf(__builtin_rintf(v[1] * 255.0f), 1.0f), 1u, w);
        w = __builtin_amdgcn_cvt_pk_u8_f32(fmaxf(__builtin_rintf(v[2] * 255.0f), 1.0f), 2u, w); w = __builtin_amdgcn_cvt_pk_u8_f32(fmaxf(__builtin_rintf(v[3] * 255.0f), 1.0f), 3u, w); return w; }
    __device__ __forceinline__ void operator()(const f32x4 (&acc)[2][2][4][2], const Unit& u, int wr_, int wc_, int, int) const {
        typedef unsigned u32x2v __attribute__((ext_vector_type(2)));
        int wr = wr_, wc = wc_; asm volatile("" : "+s"(wr), "+s"(wc));
        const int lane_ = mk_lane(), fr = lane_ & 15, fq = lane_ >> 4;
        const int row0 = u.pm * BM + wr * 64 + fr, col0 = u.pn * BM + wc * 32 + 8 * fq;
        f32x4 bv[2][2];
#pragma unroll
        for (int bj = 0; bj < 2; ++bj)
#pragma unroll
            for (int n = 0; n < 2; ++n) bv[bj][n] = *(const f32x4*)(bias + col0 + bj * HALF + 4 * n) * -1.4426950408889634f;
#pragma unroll
        for (int ai = 0; ai < 2; ++ai)
#pragma unroll
            for (int m = 0; m < 4; ++m) { const float r = rs[row0 + ai * HALF + m * 16] * (wsc * -1.4426950408889634f); unsigned char* rowp = O + (size_t)(row0 + ai * HALF + m * 16) * ldc + col0;
#pragma unroll
                for (int bj = 0; bj < 2; ++bj) { f32x4 v0 = acc[ai][bj][m][0] * r + bv[bj][0], v1 = acc[ai][bj][m][1] * r + bv[bj][1];
#pragma unroll
                    for (int e = 0; e < 4; ++e) { v0[e] = __builtin_amdgcn_rcpf(1.0f + __builtin_amdgcn_exp2f(v0[e])); v1[e] = __builtin_amdgcn_rcpf(1.0f + __builtin_amdgcn_exp2f(v1[e])); }
                    u32x2v w; w.x = pk_u8x4(v0); w.y = pk_u8x4(v1); *(u32x2v*)(rowp + bj * HALF) = w; } }
    }
};
template <int ACT> struct EpiBf16 {
    static constexpr bool PERM = true, AFTER_DRAIN = false, LV = (ACT == 0);     static constexpr int NST = 16;
    bf16_t* O; int ldc;
    __device__ __forceinline__ void operator()(const f32x4 (&acc)[2][2][4][2], const Unit& u, int wr, int wc, int fr, int fq) const {
        const int row0 = u.pm * BM + wr * 64 + fr, col0 = u.pn * BM + wc * 32 + 8 * fq;
#pragma unroll
        for (int ai = 0; ai < 2; ++ai)
#pragma unroll
            for (int m = 0; m < 4; ++m) { bf16_t* rowp = O + (size_t)(row0 + ai * HALF + m * 16) * ldc + col0;
#pragma unroll
                for (int bj = 0; bj < 2; ++bj) { f32x4 v0 = acc[ai][bj][m][0], v1 = acc[ai][bj][m][1];
                    if (ACT == 1) {
#pragma unroll
                        for (int e = 0; e < 4; ++e) { const float a = __builtin_amdgcn_fmed3f(v0[e], 0.f, __builtin_inff()), b = __builtin_amdgcn_fmed3f(v1[e], 0.f, __builtin_inff()); v0[e] = a * a; v1[e] = b * b; } }
                    PG8_ST16(rowp + bj * HALF, pack8(v0, v1)); } }
    }
};
template <int MODE> struct EpiGate {
    static constexpr bool PERM = true, AFTER_DRAIN = false, LV = false; static constexpr int NST = 16;
    static constexpr int ldc = 2048, ldg = 22528;
    bf16_t* O; const unsigned char* Zg; const bf16_t* P;
    __device__ __forceinline__ void operator()(const f32x4 (&acc)[2][2][4][2], const Unit& u, int wr, int wc, int fr, int fq) const {
        const int row0 = u.pm * BM + wr * 64 + fr, col0 = u.pn * BM + wc * 32 + 8 * fq;
#pragma unroll
        for (int ai = 0; ai < 2; ++ai)
#pragma unroll
            for (int m = 0; m < 4; ++m) { const size_t r = (size_t)(row0 + ai * HALF + m * 16);
#pragma unroll
                for (int bj = 0; bj < 2; ++bj) {
                    typedef unsigned u32x2v __attribute__((ext_vector_type(2)));
                    const u32x2v g = *(const u32x2v*)(Zg + r * ldg + col0 + bj * HALF); constexpr float q = 1.0f / 255.0f;
                    f32x4 v0 = acc[ai][bj][m][0] * ((f32x4){(float)(g.x & 255u), (float)((g.x >> 8) & 255u), (float)((g.x >> 16) & 255u), (float)(g.x >> 24)} * q);
                    f32x4 v1 = acc[ai][bj][m][1] * ((f32x4){(float)(g.y & 255u), (float)((g.y >> 8) & 255u), (float)((g.y >> 16) & 255u), (float)(g.y >> 24)} * q);
                    if (MODE == 1) { const u32x4 p = *(const u32x4*)(P + r * ldc + col0 + bj * HALF);
                        v0 += (f32x4){bf_lo(p.x), bf_hi(p.x), bf_lo(p.y), bf_hi(p.y)}; v1 += (f32x4){bf_lo(p.z), bf_hi(p.z), bf_lo(p.w), bf_hi(p.w)}; }
                    PG8_ST16(O + r * ldc + col0 + bj * HALF, pack8(v0, v1)); } }
    }
};
struct EpiGateDual {
    static constexpr bool PERM = true, AFTER_DRAIN = false, LV = false; static constexpr int NST = 16;
    static constexpr int ldc = 2048, ldg = 22528, gboff = 2048;
    bf16_t* O; const unsigned char* Zg;
#define EGD_U8(w) (f32x4){(float)((w) & 255u), (float)(((w) >> 8) & 255u), (float)(((w) >> 16) & 255u), (float)((w) >> 24)}
    __device__ __forceinline__ void mid(f32x4 (&acc)[2][2][4][2], const Unit& u, int wr, int wc, int fr, int fq) const {
        typedef unsigned u32x2v __attribute__((ext_vector_type(2)));
        const int row0 = u.pm * BM + wr * 64 + fr, col0 = u.pn * BM + wc * 32 + 8 * fq;
        u32x2v ga[2][4][2], gb[2][4][2];
#pragma unroll
        for (int ai = 0; ai < 2; ++ai)
#pragma unroll
            for (int m = 0; m < 4; ++m)
#pragma unroll
                for (int bj = 0; bj < 2; ++bj) { const unsigned char* gp = Zg + (size_t)(row0 + ai * HALF + m * 16) * ldg + col0 + bj * HALF;
                    ga[ai][m][bj] = *(const u32x2v*)gp; gb[ai][m][bj] = *(const u32x2v*)(gp + gboff); }
        __builtin_amdgcn_sched_barrier(0);
#pragma unroll
        for (int ai = 0; ai < 2; ++ai)
#pragma unroll
            for (int m = 0; m < 4; ++m)
#pragma unroll
                for (int bj = 0; bj < 2; ++bj) {
                    const f32x4 b0 = EGD_U8(gb[ai][m][bj].x), b1 = EGD_U8(gb[ai][m][bj].y);
                    const f32x4 r0 = {__builtin_amdgcn_rcpf(b0[0]), __builtin_amdgcn_rcpf(b0[1]), __builtin_amdgcn_rcpf(b0[2]), __builtin_amdgcn_rcpf(b0[3])}, r1 = {__builtin_amdgcn_rcpf(b1[0]), __builtin_amdgcn_rcpf(b1[1]), __builtin_amdgcn_rcpf(b1[2]), __builtin_amdgcn_rcpf(b1[3])};
                    acc[ai][bj][m][0] = acc[ai][bj][m][0] * (EGD_U8(ga[ai][m][bj].x) * r0); acc[ai][bj][m][1] = acc[ai][bj][m][1] * (EGD_U8(ga[ai][m][bj].y) * r1); }
    }
    __device__ __forceinline__ void operator()(const f32x4 (&acc)[2][2][4][2], const Unit& u, int wr, int wc, int fr, int fq) const {
        typedef unsigned u32x2v __attribute__((ext_vector_type(2)));
        const int row0 = u.pm * BM + wr * 64 + fr, col0 = u.pn * BM + wc * 32 + 8 * fq; constexpr float q = 1.0f / 255.0f;
#pragma unroll
        for (int ai = 0; ai < 2; ++ai)
#pragma unroll
            for (int m = 0; m < 4; ++m) { const size_t r = (size_t)(row0 + ai * HALF + m * 16);
#pragma unroll
                for (int bj = 0; bj < 2; ++bj) { const u32x2v gb = *(const u32x2v*)(Zg + r * ldg + gboff + col0 + bj * HALF);
                    const f32x4 v0 = acc[ai][bj][m][0] * (EGD_U8(gb.x) * q), v1 = acc[ai][bj][m][1] * (EGD_U8(gb.y) * q);
                    PG8_ST16(O + r * ldc + col0 + bj * HALF, pack8(v0, v1)); } }
    }
#undef EGD_U8
};
struct EpiF32 {
    static constexpr bool PERM = false, AFTER_DRAIN = false, LV = false; static constexpr int NST = 32;
    float* O; int ldc;
    __device__ __forceinline__ void operator()(const f32x4 (&acc)[2][2][4][2], const Unit& u, int wr, int wc, int fr, int fq) const {
        const int row0 = u.pm * BM + wr * 64 + fr, col0 = u.pn * BM + wc * 32 + 4 * fq;
#pragma unroll
        for (int ai = 0; ai < 2; ++ai)
#pragma unroll
            for (int m = 0; m < 4; ++m) { float* rowp = O + (size_t)(row0 + ai * HALF + m * 16) * ldc + col0;
#pragma unroll
                for (int bj = 0; bj < 2; ++bj)
#pragma unroll
                    for (int n = 0; n < 2; ++n) *(f32x4*)(rowp + bj * HALF + n * 16) = acc[ai][bj][m][n]; }
    }
};

__device__ __forceinline__ void glds16_asm(const void* sbase  , unsigned voff, unsigned lds_dst) { unsigned keep;
    asm volatile("s_mov_b32 %0, m0\n\ts_mov_b32 m0, %3\n\ts_nop 0\n\tglobal_load_lds_dwordx4 %1, %2\n\ts_mov_b32 m0, %0" : "=&s"(keep) : "v"(voff), "s"(sbase), "s"(lds_dst) : "memory"); }
template <bool L> __device__ __forceinline__ unsigned pg8_lv(unsigned v) { if constexpr (L) asm volatile("" : "+v"(v)); return v; }
template <class Epi, class Sched, bool ALIGN_EPI = false, bool SP2 = false, bool FP8 = false>
__device__ __forceinline__ void gemm_phase(PG8_LAS unsigned char* lds, const Gemm g, const Sched& S, const Epi& E, const int wave_s) {
    int tid_ = wave_s * 64 + mk_lane(); asm volatile("" : "+v"(tid_));
    int wid_ = wave_s; asm volatile("" : "+s"(wid_));
    const int tid = tid_, wid = wid_, lane = tid & 63, wr = wid >> 2, wc = wid & 3, fr = lane & 15, fq = lane >> 4;
    const int KB = FP8 ? g.K : 2 * g.K, nt = KB / (2 * BK);
    unsigned voffA[2], voffB[2];
#pragma unroll
    for (int i = 0; i < 2; ++i) { int R, C; stage_rc(tid * 16 + i * 8192, R, C); const int Rb = Epi::PERM ? ((R & ~31) + perm32(R & 31)) : R;
        voffA[i] = (unsigned)(R * KB + C * 2); voffB[i] = (unsigned)(Rb * KB + C * 2); }
    const size_t kstep = (size_t)(BK * 2);
    const size_t hstep = (size_t)HALF * KB;
    const size_t tstep = 2 * hstep;
    const unsigned ldsw = (unsigned)wid * 1024u;
    const int aoff = lds_byte(wr * 64 + fr, fq * 8), boff = lds_byte(wc * 32 + fr, fq * 8);
#define PG8_SA(b, h) (((b) * 2 + (h)) * HTB)
#define PG8_SB(b, h) ((4 + (b) * 2 + (h)) * HTB)
#define PG8_STAGE(bufoff, gbase, voff) do { _Pragma("unroll") for (int _i = 0; _i < 2; ++_i) \
        __builtin_amdgcn_global_load_lds((const unsigned*)((const char*)(gbase) + pg8_lv<(FP8 || Epi::LV)>((voff)[_i])), (PG8_LAS unsigned*)(lds + (bufoff) + ldsw + _i * 8192), 16, 0, 0); } while (0)
#define PG8_LDA(dst, b, h) do { _Pragma("unroll") for (int m = 0; m < 4; ++m) _Pragma("unroll") for (int k = 0; k < 2; ++k) dst[m][k] = *(const PG8_LAS bf16x8*)(lds + PG8_SA(b, h) + aoff + m * 2048 + k * 1024); } while (0)
#define PG8_LDB(dst, b, h) do { _Pragma("unroll") for (int n = 0; n < 2; ++n) _Pragma("unroll") for (int k = 0; k < 2; ++k) dst[n][k] = *(const PG8_LAS bf16x8*)(lds + PG8_SB(b, h) + boff + n * 2048 + k * 1024); } while (0)
#define PG8_CAT(x0, x1) __builtin_bit_cast(v8i32, __builtin_shufflevector((x0), (x1), 0, 1, 2, 3, 4, 5, 6, 7, 8, 9, 10, 11, 12, 13, 14, 15))
#define PG8_MMA(ai, bj, At, Bt) do { __builtin_amdgcn_s_setprio(1); _Pragma("unroll") for (int m = 0; m < 4; ++m) _Pragma("unroll") for (int n = 0; n < 2; ++n) { \
        if constexpr (FP8) acc[ai][bj][m][n] = __builtin_amdgcn_mfma_scale_f32_16x16x128_f8f6f4(PG8_CAT(Bt[n][0], Bt[n][1]), PG8_CAT(At[m][0], At[m][1]), acc[ai][bj][m][n], 0, 0, 0, 0, 0, 0); \
        else { _Pragma("unroll") for (int k = 0; k < 2; ++k) acc[ai][bj][m][n] = __builtin_amdgcn_mfma_f32_16x16x32_bf16(Bt[n][k], At[m][k], acc[ai][bj][m][n], 0, 0, 0); } } __builtin_amdgcn_s_setprio(0); } while (0)
#if defined(PG8_SAFE_WAITS) && PG8_SAFE_WAITS
#define PG8_WAIT_V(n) asm volatile("s_waitcnt vmcnt(0)" ::: "memory")
#else
#define PG8_WAIT_V(n) asm volatile("s_waitcnt vmcnt(" #n ")" ::: "memory")
#endif
#define PG8_WAIT_L(n) asm volatile("s_waitcnt lgkmcnt(" #n ")" ::: "memory")
#if defined(PG8_SAFE_WAITS) && PG8_SAFE_WAITS
#define PG8_WAIT_VR(r) asm volatile("s_waitcnt vmcnt(0)" ::: "memory")
#else
#define PG8_WAIT_VR(r) do { if (r) { if constexpr (Epi::NST >= 16) asm volatile("s_waitcnt vmcnt(24)" ::: "memory"); else { static_assert(Epi::NST >= 8, "relaxed waits: at least 8 epilogue stores"); asm volatile("s_waitcnt vmcnt(16)" ::: "memory"); } } else asm volatile("s_waitcnt vmcnt(8)" ::: "memory"); } while (0)
#endif
#define PG8_BAR __builtin_amdgcn_s_barrier()
#define PG8_SCHED __builtin_amdgcn_sched_barrier(0)
    Unit cur, nxt; int ui = 0;
    if (!S.next(0, cur)) return;
    f32x4 acc[2][2][4][2];
#pragma unroll
    for (int a = 0; a < 2; ++a)
#pragma unroll
        for (int b = 0; b < 2; ++b)
#pragma unroll
            for (int m = 0; m < 4; ++m)
#pragma unroll
                for (int n = 0; n < 2; ++n) acc[a][b][m][n] = (f32x4){0.f, 0.f, 0.f, 0.f};
    bf16x8 At[4][2], B0[2][2], B1[2][2];
    const char* cA = (const char*)g.A + (size_t)cur.pm * tstep; const char* cB = (const char*)g.Bt + (size_t)cur.pn * tstep;
    S.a_ready(cur);
    if constexpr (SP2) {
        PG8_STAGE(PG8_SB(0, 0), cB, voffB); PG8_STAGE(PG8_SB(0, 1), cB + hstep, voffB); PG8_STAGE(PG8_SA(0, 0), cA, voffA); PG8_STAGE(PG8_SA(0, 1), cA + hstep, voffA);
        if (wr == 1) PG8_BAR;
        PG8_WAIT_V(2); PG8_BAR;
        PG8_STAGE(PG8_SB(1, 0), cB + kstep, voffB); PG8_STAGE(PG8_SA(1, 0), cA + kstep, voffA); PG8_STAGE(PG8_SB(1, 1), cB + hstep + kstep, voffB);
        PG8_WAIT_V(6); PG8_BAR;
    } else {
        PG8_STAGE(PG8_SB(0, 0), cB, voffB); PG8_STAGE(PG8_SA(0, 0), cA, voffA); PG8_STAGE(PG8_SB(0, 1), cB + hstep, voffB); PG8_STAGE(PG8_SA(0, 1), cA + hstep, voffA);
        if (wr == 1) PG8_BAR;
        PG8_WAIT_V(4); PG8_BAR;
        PG8_STAGE(PG8_SB(1, 0), cB + kstep, voffB); PG8_STAGE(PG8_SA(1, 0), cA + kstep, voffA); PG8_STAGE(PG8_SB(1, 1), cB + hstep + kstep, voffB);
        PG8_WAIT_V(6); PG8_BAR;
    }
    for (;;) {
        const int lt_ = mk_lane(), fr = lt_ & 15, fq = lt_ >> 4;
        unsigned voffA[2], voffB[2];
#pragma unroll
        for (int i = 0; i < 2; ++i) { int R, C; stage_rc((wid * 64 + lt_) * 16 + i * 8192, R, C); const int Rb = Epi::PERM ? ((R & ~31) + perm32(R & 31)) : R;
            voffA[i] = (unsigned)(R * KB + C * 2); voffB[i] = (unsigned)(Rb * KB + C * 2); }
        const int aoff = lds_byte(wr * 64 + fr, fq * 8), boff = lds_byte(wc * 32 + fr, fq * 8);
        const bool has_next = S.next(ui + 1, nxt);
        const char* nA = has_next ? (const char*)g.A + (size_t)nxt.pm * tstep : cA; const char* nB = has_next ? (const char*)g.Bt + (size_t)nxt.pn * tstep : cB;
#define PG8_PAIR_SP2(RLX, t) PG8_PAIR_SP2X(RLX, t, cA, cB, nA, nB)
          \
#define PG8_PAIR_SP2X(RLX, t, BA, BB, NXA, NXB) do { \
            const bool last = ((t) == nt - 2); \
            const char* a1 = (BA) + (size_t)((t) + 1) * kstep; \
            const char* a2 = last ? (NXA) : (BA) + (size_t)((t) + 2) * kstep; const char* b2 = last ? (NXB) : (BB) + (size_t)((t) + 2) * kstep; \
            const char* a3 = a2 + kstep; const char* b3 = b2 + kstep; \
            if (last && has_next) S.a_ready(nxt); \
            PG8_LDB(B0, 0, 0); PG8_LDB(B1, 0, 1); PG8_SCHED; PG8_LDA(At, 0, 0); if (!(RLX)) PG8_STAGE(PG8_SA(1, 1), a1 + hstep, voffA); \
            PG8_WAIT_VR(RLX); PG8_WAIT_L(0); PG8_BAR; PG8_MMA(0, 0, At, B0); PG8_MMA(0, 1, At, B1); PG8_BAR; PG8_SCHED; \
            PG8_LDA(At, 0, 1); PG8_STAGE(PG8_SB(0, 0), b2, voffB); PG8_STAGE(PG8_SB(0, 1), b2 + hstep, voffB); PG8_STAGE(PG8_SA(0, 0), a2, voffA); \
            PG8_WAIT_VR(RLX); PG8_WAIT_L(0); PG8_BAR; PG8_MMA(1, 0, At, B0); PG8_MMA(1, 1, At, B1); PG8_BAR; PG8_SCHED; \
            PG8_LDB(B0, 1, 0); PG8_LDB(B1, 1, 1); PG8_SCHED; PG8_LDA(At, 1, 0); PG8_STAGE(PG8_SA(0, 1), a2 + hstep, voffA); \
            PG8_WAIT_VR(RLX); PG8_WAIT_L(0); PG8_BAR; PG8_MMA(0, 0, At, B0); PG8_MMA(0, 1, At, B1); PG8_BAR; PG8_SCHED; \
            PG8_LDA(At, 1, 1); PG8_STAGE(PG8_SB(1, 0), b3, voffB); PG8_STAGE(PG8_SB(1, 1), b3 + hstep, voffB); PG8_STAGE(PG8_SA(1, 0), a3, voffA); \
            PG8_WAIT_V(8); PG8_WAIT_L(0); PG8_BAR; PG8_MMA(1, 0, At, B0); PG8_MMA(1, 1, At, B1); PG8_BAR; PG8_SCHED; } while (0)
        if constexpr (SP2) {
#if PG8_RELAX == 2
            for (int t = 0; t < nt; t += 2) { const bool rlx = (t == 0) && (ui > 0); PG8_PAIR_SP2(rlx, t); }
#else
            int t0 = 0;
            if constexpr (Sched::DUAL) {
                const char* cA2 = S.opA2() + (size_t)cur.pm * tstep; const char* cB2 = S.opB2() + (size_t)cur.pn * tstep;
                if constexpr (PG8_RELAX) { if (ui > 0) { PG8_PAIR_SP2X(1, 0, cA, cB, cA2, cB2); t0 = 2; } }
                for (int t = t0; t < nt; t += 2) PG8_PAIR_SP2X(0, t, cA, cB, cA2, cB2);
                {   Unit um = cur; asm volatile("" : "+s"(um.pm), "+s"(um.pn)); const int lm_ = mk_lane(); E.mid(acc, um, wr, wc, lm_ & 15, lm_ >> 4); }
                for (int t = 0; t < nt; t += 2) PG8_PAIR_SP2X(0, t, cA2, cB2, nA, nB);
            } else {
            if constexpr (PG8_RELAX) { if (ui > 0) { PG8_PAIR_SP2(1, 0); t0 = 2; } }
            for (int t = t0; t < nt; t += 2) PG8_PAIR_SP2(0, t);
            }
#endif
        } else {
        for (int t = 0; t < nt; t += 2) {
            const bool last = (t == nt - 2);
            const char* a1 = cA + (size_t)(t + 1) * kstep;
            const char* a2 = last ? nA : cA + (size_t)(t + 2) * kstep; const char* b2 = last ? nB : cB + (size_t)(t + 2) * kstep;
            const char* a3 = a2 + kstep; const char* b3 = b2 + kstep;
            if (last && has_next) S.a_ready(nxt);
            PG8_LDB(B0, 0, 0); PG8_SCHED; PG8_LDA(At, 0, 0); PG8_STAGE(PG8_SA(1, 1), a1 + hstep, voffA);
            PG8_WAIT_L(8); PG8_BAR; PG8_WAIT_L(0); PG8_MMA(0, 0, At, B0); PG8_BAR; PG8_SCHED;
            PG8_LDB(B1, 0, 1); PG8_STAGE(PG8_SB(0, 0), b2, voffB);
            PG8_BAR; PG8_WAIT_L(0); PG8_MMA(0, 1, At, B1); PG8_BAR;
            PG8_LDA(At, 0, 1); PG8_STAGE(PG8_SA(0, 0), a2, voffA);
            PG8_BAR; PG8_WAIT_L(0); PG8_MMA(1, 0, At, B0); PG8_BAR; PG8_SCHED;
            PG8_STAGE(PG8_SB(0, 1), b2 + hstep, voffB);
            PG8_WAIT_V(6); PG8_BAR; PG8_MMA(1, 1, At, B1); PG8_BAR;
            PG8_LDB(B0, 1, 0); PG8_SCHED; PG8_LDA(At, 1, 0); PG8_STAGE(PG8_SA(0, 1), a2 + hstep, voffA);
            PG8_WAIT_L(8); PG8_BAR; PG8_WAIT_L(0); PG8_MMA(0, 0, At, B0); PG8_BAR; PG8_SCHED;
            PG8_LDB(B1, 1, 1); PG8_STAGE(PG8_SB(1, 0), b3, voffB);
            PG8_BAR; PG8_WAIT_L(0); PG8_MMA(0, 1, At, B1); PG8_BAR;
            PG8_LDA(At, 1, 1); PG8_STAGE(PG8_SA(1, 0), a3, voffA);
            PG8_BAR; PG8_WAIT_L(0); PG8_MMA(1, 0, At, B0); PG8_BAR; PG8_SCHED;
            PG8_STAGE(PG8_SB(1, 1), b3 + hstep, voffB);
            PG8_WAIT_V(6); PG8_BAR; PG8_MMA(1, 1, At, B1); PG8_BAR;
        }
        }
#undef PG8_PAIR_SP2
#undef PG8_PAIR_SP2X
        if constexpr (ALIGN_EPI) { if (wr == 0) PG8_BAR; }
        if constexpr (SP2 && PG8_RELAX) { if (has_next) {
            const char* eb = nA + kstep + hstep;
#pragma unroll
            for (int i_ = 0; i_ < 2; ++i_) { unsigned vo_ = voffA[i_]; asm volatile("" : "+v"(vo_));
                glds16_asm(eb, vo_, (unsigned)__builtin_amdgcn_readfirstlane((int)(unsigned)(size_t)(lds + PG8_SA(1, 1)) + (int)ldsw + i_ * 8192)); }
            PG8_SCHED; } }
        if constexpr (!Epi::AFTER_DRAIN) { Unit ue = cur; asm volatile("" : "+s"(ue.pm), "+s"(ue.pn));
            const int le_ = mk_lane(); E(acc, ue, wr, wc, le_ & 15, le_ >> 4); S.done(cur); }
        if (!has_next) break;
#pragma unroll
        for (int a = 0; a < 2; ++a)
#pragma unroll
            for (int b = 0; b < 2; ++b)
#pragma unroll
                for (int m = 0; m < 4; ++m)
#pragma unroll
                    for (int n = 0; n < 2; ++n) acc[a][b][m][n] = (f32x4){0.f, 0.f, 0.f, 0.f};
        cur = nxt; cA = nA; cB = nB; ++ui;
        if constexpr (ALIGN_EPI) { if (wr == 1) PG8_BAR; }
    }
    PG8_WAIT_V(0);
    if constexpr (!ALIGN_EPI) { if (wr == 0) PG8_BAR; }
    PG8_BAR;
    if constexpr (Epi::AFTER_DRAIN) { E.fused(acc, cur, wr, wc, fr, fq, lds, wid, lane); S.done(cur); }
#undef PG8_SA
#undef PG8_SB
#undef PG8_STAGE
#undef PG8_LDA
#undef PG8_LDB
#undef PG8_MMA
#undef PG8_CAT
#undef PG8_WAIT_V
#undef PG8_WAIT_L
#undef PG8_WAIT_VR
#undef PG8_BAR
#undef PG8_SCHED
}
}

namespace att {
typedef unsigned short bf16_t;
using bf16x8 = __attribute__((ext_vector_type(8))) short;
using s16x4  = __attribute__((ext_vector_type(4))) short;
using f32x16 = __attribute__((ext_vector_type(16))) float;
using f32x4  = __attribute__((ext_vector_type(4))) float;
using u32x4  = __attribute__((ext_vector_type(4))) unsigned;
#define ATT_LAS __attribute__((address_space(3)))
constexpr int   D = 128, NW = 8, QBLK = 32, KVBLK = 64;
constexpr float SCALE = 0.088388347648318440f;
constexpr float THR = 8.f;
constexpr int SHM_V = KVBLK * D * 2, SHM_K = KVBLK * D * 2, SHM_ATTN = 2 * SHM_V + 2 * SHM_K + NW * 64 * 4;
#define KSWZ(row, colB) ((row) * 256 + ((colB) ^ (((row) & 7) << 4)))
#define SBAR() __builtin_amdgcn_sched_barrier(0)
__device__ __forceinline__ int crow(int r, int hi) { return (r & 3) + 8 * (r >> 2) + 4 * hi; }
typedef float f32x2_t __attribute__((ext_vector_type(2)));
typedef __bf16 bf16x2_t __attribute__((ext_vector_type(2)));
__device__ __forceinline__ unsigned cvtpk(float lo, float hi) { const f32x2_t v = {lo, hi}; const bf16x2_t b = __builtin_convertvector(v, bf16x2_t); return __builtin_bit_cast(unsigned, b); }

template <bool FIXED> __device__ __forceinline__ void partialSM(f32x16& p0, f32x16& p1, float& m_reg, float& mn, float& alpha, const float mCfix) {
  constexpr float C = SCALE * 1.4426950408889634f;
  if constexpr (FIXED) { alpha = 1.f; mn = 0.f; (void)mCfix;
#pragma unroll
    for (int r = 0; r < 16; ++r) p0[r] = __builtin_amdgcn_exp2f(p0[r]);
    return; }
  float pmax = p0[0];
#pragma unroll
  for (int r = 1; r < 16; ++r) pmax = fmaxf(pmax, p0[r]);
#pragma unroll
  for (int r = 0; r < 16; ++r) pmax = fmaxf(pmax, p1[r]);
  { auto rr = __builtin_amdgcn_permlane32_swap(__float_as_uint(pmax), __float_as_uint(pmax), false, false);
    pmax = fmaxf(__uint_as_float(rr[0]), __uint_as_float(rr[1])); }
  if (__builtin_expect(__all(pmax - m_reg <= THR / SCALE), 1)) { mn = m_reg; alpha = 1.f; }
  else { mn = fmaxf(m_reg, pmax); alpha = __builtin_amdgcn_exp2f((m_reg - mn) * C); m_reg = mn; }
  float mnC = -mn * C;
#pragma unroll
  for (int r = 0; r < 16; ++r) p0[r] = fmaf(p0[r], C, mnC);
#pragma unroll
  for (int r = 0; r < 16; ++r) p1[r] = fmaf(p1[r], C, mnC);
#pragma unroll
  for (int r = 0; r < 16; ++r) p0[r] = __builtin_amdgcn_exp2f(p0[r]);
}
__device__ __forceinline__ void finishSM(f32x16& p0, f32x16& p1, float alpha, float& l_reg, bf16x8& pa0, bf16x8& pa1, bf16x8& pa2, bf16x8& pa3) {
#pragma unroll
  for (int r = 0; r < 16; ++r) p1[r] = __builtin_amdgcn_exp2f(p1[r]);
  float ps = 0;
#pragma unroll
  for (int r = 0; r < 16; ++r) ps += p0[r];
#pragma unroll
  for (int r = 0; r < 16; ++r) ps += p1[r];
  { auto rr = __builtin_amdgcn_permlane32_swap(__float_as_uint(ps), __float_as_uint(ps), false, false);
    ps = __uint_as_float(rr[0]) + __uint_as_float(rr[1]); }
  l_reg = l_reg * alpha + ps;
#define PK4(P, BASE, OUT) do { unsigned a0 = cvtpk(P[BASE + 0], P[BASE + 1]), a1 = cvtpk(P[BASE + 2], P[BASE + 3]);   \
    unsigned b0 = cvtpk(P[BASE + 4], P[BASE + 5]), b1 = cvtpk(P[BASE + 6], P[BASE + 7]);                              \
    auto r0 = __builtin_amdgcn_permlane32_swap(a0, b0, false, false); auto r1 = __builtin_amdgcn_permlane32_swap(a1, b1, false, false); \
    u32x4 w = {r0[0], r1[0], r0[1], r1[1]}; OUT = __builtin_bit_cast(bf16x8, w); } while (0)
  PK4(p0, 0, pa0); PK4(p0, 8, pa1); PK4(p1, 0, pa2); PK4(p1, 8, pa3);
#undef PK4
}
template <bool FIXED> __device__ __forceinline__ void qkt(f32x16& p0, f32x16& p1, const ATT_LAS char* Ks, const bf16x8* qr, int r32, int hi, const f32x16& cinit) {
  if constexpr (!FIXED) { p0 = f32x16{}; p1 = f32x16{}; }
#pragma unroll
  for (int d0 = 0; d0 < 8; ++d0) { int cb = (d0 * 16 + hi * 8) * 2;
    bf16x8 b0 = *(const ATT_LAS bf16x8*)(Ks + KSWZ(r32, cb));
    bf16x8 b1 = *(const ATT_LAS bf16x8*)(Ks + KSWZ(32 + r32, cb));
    if (FIXED && d0 == 0) { p0 = __builtin_amdgcn_mfma_f32_32x32x16_bf16(b0, qr[d0], cinit, 0, 0, 0); p1 = __builtin_amdgcn_mfma_f32_32x32x16_bf16(b1, qr[d0], cinit, 0, 0, 0); }
    else { p0 = __builtin_amdgcn_mfma_f32_32x32x16_bf16(b0, qr[d0], p0, 0, 0, 0); p1 = __builtin_amdgcn_mfma_f32_32x32x16_bf16(b1, qr[d0], p1, 0, 0, 0); } }
}
__device__ __forceinline__ int v_st(int k, int c) { const int kk = (k & ~0xC) | ((k & 4) << 1) | ((k & 8) >> 1); return ((kk >> 3) * 4 + (c >> 5)) * 512 + ((kk & 7) * 32 + (c & 31)) * 2; }
__device__ __forceinline__ int v_rd_base(int lane) { return ((lane & 3) << 3) | (((lane >> 2) & 3) << 6) | (((lane >> 4) & 1) << 5) | (((lane >> 5) & 1) << 8); }
constexpr int v_rd_off(int d0, int ks, int half) { return d0 * 512 + ks * 4096 + half * 2048; }
template <int OFF> __device__ __forceinline__ s16x4 tr_read(int vb) {
  s16x4 r; asm volatile("ds_read_b64_tr_b16 %0, %1 offset:%2" : "=&v"(r) : "v"(vb), "i"(OFF) : "memory"); return r;
}
template <int D0> __device__ __forceinline__ void pv_one(f32x16& od, int vb, bf16x8 pa0, bf16x8 pa1, bf16x8 pa2, bf16x8 pa3) {
  const s16x4 l0 = tr_read<v_rd_off(D0, 0, 0)>(vb), h0 = tr_read<v_rd_off(D0, 0, 1)>(vb), l1 = tr_read<v_rd_off(D0, 1, 0)>(vb), h1 = tr_read<v_rd_off(D0, 1, 1)>(vb);
  const s16x4 l2 = tr_read<v_rd_off(D0, 2, 0)>(vb), h2 = tr_read<v_rd_off(D0, 2, 1)>(vb), l3 = tr_read<v_rd_off(D0, 3, 0)>(vb), h3 = tr_read<v_rd_off(D0, 3, 1)>(vb);
  asm volatile("s_waitcnt lgkmcnt(0)" ::: "memory"); SBAR();
#define PK(L, H) (bf16x8){L[0], L[1], L[2], L[3], H[0], H[1], H[2], H[3]}
  od = __builtin_amdgcn_mfma_f32_32x32x16_bf16(pa0, PK(l0, h0), od, 0, 0, 0);
  od = __builtin_amdgcn_mfma_f32_32x32x16_bf16(pa1, PK(l1, h1), od, 0, 0, 0);
  od = __builtin_amdgcn_mfma_f32_32x32x16_bf16(pa2, PK(l2, h2), od, 0, 0, 0);
  od = __builtin_amdgcn_mfma_f32_32x32x16_bf16(pa3, PK(l3, h3), od, 0, 0, 0);
#undef PK
}
__device__ __forceinline__ void pv_d0(f32x16* o, int vb, bf16x8 pa0, bf16x8 pa1, bf16x8 pa2, bf16x8 pa3) {
  pv_one<0>(o[0], vb, pa0, pa1, pa2, pa3); pv_one<1>(o[1], vb, pa0, pa1, pa2, pa3); pv_one<2>(o[2], vb, pa0, pa1, pa2, pa3); pv_one<3>(o[3], vb, pa0, pa1, pa2, pa3);
}
__device__ __forceinline__ float bflo(unsigned w) { return __uint_as_float(w << 16); }
__device__ __forceinline__ float bfhi(unsigned w) { return __uint_as_float(w & 0xffff0000u); }

template <int LDQ, int LDK, int LDO, bool FIXED>
__device__ __forceinline__ void attn_unit(const bf16_t* __restrict__ Qb, const bf16_t* __restrict__ Kh, const bf16_t* __restrict__ Vh, bf16_t* __restrict__ Ob,
                                          int t0, const float* __restrict__ qg, const float* __restrict__ rope, int seq, ATT_LAS char* lds, const int wave_s, const float mCfix) {
  int tid_ = wave_s * 64 + mk_lane(); asm volatile("" : "+v"(tid_));
  int wid_ = wave_s; asm volatile("" : "+s"(wid_));
  const int tid = tid_, wid = wid_, lane = tid & 63, r32 = lane & 31, hi = lane >> 5;
  ATT_LAS char* V_lds = lds; ATT_LAS char* K_lds = lds + 2 * SHM_V;
  ATT_LAS float* ws = (ATT_LAS float*)(lds + 2 * SHM_V + 2 * SHM_K) + wid * 64; ATT_LAS float* li_l = ws; ATT_LAS float* al_l = ws + 32;
  float m_reg = -1e30f, l_reg = 0; f32x16 o[4] = {}; bf16x8 qr[8];
  f32x16 cinit;
#pragma unroll
  for (int r = 0; r < 16; ++r) cinit[r] = FIXED ? mCfix : 0.f;
  {
    const bf16_t* Qw = Qb + (size_t)(wid * QBLK + r32) * LDQ + hi * 8;
#pragma unroll
    for (int d0 = 0; d0 < 8; ++d0) qr[d0] = *(const bf16x8*)(Qw + d0 * 16);
    (void)qg; (void)rope; (void)t0;
  }
  const int sr = tid >> 4, sc = (tid & 15) * 8, vst0 = v_st(sr, sc), vst1 = v_st(32 + sr, sc);
  const int vb0 = (int)(unsigned)(size_t)V_lds + v_rd_base(lane);
  struct { bf16x8 vs0, vs1, ks0, ks1; } sr_[2];
#define SLOAD(i, k0) do { sr_[i].vs0 = *(const bf16x8*)(Vh + (size_t)((k0) + sr) * LDK + sc); sr_[i].vs1 = *(const bf16x8*)(Vh + (size_t)((k0) + 32 + sr) * LDK + sc); \
    sr_[i].ks0 = *(const bf16x8*)(Kh + (size_t)((k0) + sr) * LDK + sc); sr_[i].ks1 = *(const bf16x8*)(Kh + (size_t)((k0) + 32 + sr) * LDK + sc); } while (0)
#define SWRITE(b, i) do { *(ATT_LAS bf16x8*)(V_lds + (b) * SHM_V + vst0) = sr_[i].vs0;          \
    *(ATT_LAS bf16x8*)(V_lds + (b) * SHM_V + vst1) = sr_[i].vs1; const int kc = sc * 2;               \
    *(ATT_LAS bf16x8*)(K_lds + (b) * SHM_K + KSWZ(sr, kc)) = sr_[i].ks0;                       \
    *(ATT_LAS bf16x8*)(K_lds + (b) * SHM_K + KSWZ(32 + sr, kc)) = sr_[i].ks1; } while (0)
#define SWAIT() asm volatile("s_waitcnt vmcnt(4)" ::: "memory")
#define RESC(a) do { if constexpr (!FIXED) if (__any((a) < 1.f)) { if (hi == 0) al_l[r32] = (a); asm volatile("s_waitcnt lgkmcnt(0)" ::: "memory"); \
    _Pragma("unroll") for (int d = 0; d < 4; ++d) _Pragma("unroll") for (int r = 0; r < 16; ++r) o[d][r] *= al_l[crow(r, hi)]; } } while (0)
  f32x16 pA0, pA1, pB0, pB1; float mnA, mnB, alA, alB; bf16x8 pa0, pa1, pa2, pa3; const int NT = seq / KVBLK;
  constexpr int SE = 0, SO = 1;
  SLOAD(SE, 0); asm volatile("s_waitcnt vmcnt(0)" ::: "memory"); SWRITE(0, SE); __syncthreads();
  qkt<FIXED>(pA0, pA1, K_lds, qr, r32, hi, cinit); partialSM<FIXED>(pA0, pA1, m_reg, mnA, alA, mCfix);
  SLOAD(SO, KVBLK); if (2 < NT) SLOAD(SE, 2 * KVBLK);
  SWAIT(); SWRITE(1, SO); __syncthreads();
  for (int j = 1; j + 1 < NT; j += 2) {
    SBAR(); qkt<FIXED>(pB0, pB1, K_lds + SHM_K, qr, r32, hi, cinit);
    finishSM(pA0, pA1, alA, l_reg, pa0, pa1, pa2, pa3); SBAR();
    SLOAD(SO, (j + 2) * KVBLK); SBAR();
    pv_d0(o, vb0, pa0, pa1, pa2, pa3); partialSM<FIXED>(pB0, pB1, m_reg, mnB, alB, mCfix);
    __syncthreads(); SWAIT(); SWRITE(0, SE);
    RESC(alB); __syncthreads();
    SBAR(); qkt<FIXED>(pA0, pA1, K_lds, qr, r32, hi, cinit);
    finishSM(pB0, pB1, alB, l_reg, pa0, pa1, pa2, pa3); SBAR();
    if (j + 3 < NT) SLOAD(SE, (j + 3) * KVBLK); SBAR();
    pv_d0(o, vb0 + SHM_V, pa0, pa1, pa2, pa3); partialSM<FIXED>(pA0, pA1, m_reg, mnA, alA, mCfix);
    __syncthreads(); SWAIT(); SWRITE(1, SO);
    RESC(alA); __syncthreads();
  }
  SBAR(); qkt<FIXED>(pB0, pB1, K_lds + SHM_K, qr, r32, hi, cinit);
  finishSM(pA0, pA1, alA, l_reg, pa0, pa1, pa2, pa3); SBAR();
  pv_d0(o, vb0, pa0, pa1, pa2, pa3); partialSM<FIXED>(pB0, pB1, m_reg, mnB, alB, mCfix);
  __syncthreads(); RESC(alB);
  finishSM(pB0, pB1, alB, l_reg, pa0, pa1, pa2, pa3); SBAR();
  pv_d0(o, vb0 + SHM_V, pa0, pa1, pa2, pa3);
  if (hi == 0) li_l[r32] = l_reg; asm volatile("s_waitcnt lgkmcnt(0)" ::: "memory");
  float rli[16];
#pragma unroll
  for (int r = 0; r < 16; ++r) rli[r] = __builtin_amdgcn_rcpf(li_l[crow(r, hi)]);
  bf16_t* Ow = Ob + (size_t)(wid * QBLK) * LDO;
#pragma unroll
  for (int r = 0; r < 16; ++r) { const int orow = crow(r, hi);
#pragma unroll
    for (int d0 = 0; d0 < 4; ++d0) { const float v = o[d0][r] * rli[r]; Ow[(size_t)orow * LDO + d0 * 32 + r32] = (bf16_t)(cvtpk(v, v) & 0xffffu); } }
#undef SLOAD
#undef SWRITE
#undef SWAIT
#undef RESC
}
}

#ifndef WGM_BIG
#define WGM_BIG 8
#endif
#ifndef WGM_SQ
#define WGM_SQ 4
#endif
#ifndef MK_PER_PHASE
#define MK_PER_PHASE 0
#endif
#ifndef PG8_SP2
#define PG8_SP2 true
#endif
#ifndef PG8_ALIGN
#define PG8_ALIGN true
#endif
constexpr int NWAVES = 8;
constexpr int BATCH = 4, SEQ = 4096, DM = 2048, DEPTH = 4, HD = 128, NQH = 16, NKVH = 4, DFF = 8192, INW = 13312;
constexpr int M = BATCH * SEQ;
constexpr int ZW = 11264;
constexpr int Z_CB = 0, Z_U = 2048, Z_Q = 4096, Z_K = 6144, Z_V = 6656, Z_GA = 7168, Z_GB = 9216;
constexpr int G_GATE0 = 9216;
constexpr float RMS_EPS = 1e-6f;
constexpr size_t MiB = 1u << 20;
constexpr size_t WS_CTL = 0, CTL_ZERO_BYTES = 1 * MiB;
constexpr size_t WS_ROPE = 1 * MiB;
constexpr size_t WS_RS = WS_ROPE + 256 * 1024;
constexpr size_t WS_W = 2 * MiB, W_LAYER = 140 * MiB;
constexpr size_t W_IN = 0, W_OC = 52 * MiB, W_OA = 60 * MiB, W_MG = 68 * MiB, W_UP = 76 * MiB, W_DN = 108 * MiB;
constexpr size_t WS_H = WS_W + DEPTH * W_LAYER;
constexpr size_t W_G8 = 36 * MiB;
constexpr int N_MAIN = 9216, N_GATE = 4096;
constexpr float G8_SCALE = 64.f;
constexpr size_t WS_Z = WS_H + 64 * MiB;
constexpr size_t WS_CA = WS_Z + 416 * MiB;
constexpr size_t WS_O = WS_CA + 64 * MiB;
constexpr size_t WS_P = WS_O + 64 * MiB;
constexpr size_t WS_G = WS_P + 64 * MiB;
constexpr size_t WS_F = WS_G + 64 * MiB;
constexpr size_t WS_X = WS_F + 64 * MiB;
constexpr size_t WS_END = WS_F + 128 * MiB;
static_assert((size_t)INW * DM * 2 <= 52 * MiB && (size_t)M * ZW * 2 <= 416 * MiB && (size_t)M * DFF * 2 <= 416 * MiB, "d_ws map");
constexpr int CW_BAR = 4096;
constexpr int RING_BYTES = 131072, LDSCTL_OFF = RING_BYTES, MISC_OFF = LDSCTL_OFF + 320, LDS_BYTES = 147456;

#define GAS __attribute__((address_space(1)))
#define LAS __attribute__((address_space(3)))
typedef unsigned short bf16;
typedef unsigned v4u __attribute__((ext_vector_type(4)));
typedef unsigned v2u __attribute__((ext_vector_type(2)));
typedef float f32x4 __attribute__((ext_vector_type(4)));
typedef GAS unsigned gu32;
#define LDS_WAIT() asm volatile("s_waitcnt lgkmcnt(0)" ::: "memory")
__device__ __forceinline__ unsigned f2bf(float f) { unsigned u = __builtin_bit_cast(unsigned, f); return (u + 0x7fffu + ((u >> 16) & 1u)) >> 16; }
typedef float f32x2_t __attribute__((ext_vector_type(2)));
typedef __bf16 bf16x2_t __attribute__((ext_vector_type(2)));
__device__ __forceinline__ unsigned pk2(float lo, float hi) { const f32x2_t v = {lo, hi}; const bf16x2_t b = __builtin_convertvector(v, bf16x2_t); return __builtin_bit_cast(unsigned, b); }
__device__ __forceinline__ unsigned pk_fp8x4(float a, float b, float c, float d) { int w = __builtin_amdgcn_cvt_pk_fp8_f32(a, b, 0, false); w = __builtin_amdgcn_cvt_pk_fp8_f32(c, d, w, true); return (unsigned)w; }
__device__ __forceinline__ float bflo(unsigned w) { return __uint_as_float(w << 16); }
__device__ __forceinline__ float bfhi(unsigned w) { return __uint_as_float(w & 0xffff0000u); }

#define XB_TMO      128
#define XB_XCNT(j)  (256  + 64 * (j))
#define XB_XSUB(j)  (1280 + 64 * (j))
#define XB_XGEN(j)  (2304 + 64 * (j))
#define XB_TOP      3328
#define XB_TOPGEN   3392
#define XCD_BAR_WORDS 3456
#define XB_SPIN_CAP (1u << 18)

__device__ __forceinline__ unsigned xb_ld(unsigned* p)              { return __hip_atomic_load(p, __ATOMIC_RELAXED, __HIP_MEMORY_SCOPE_AGENT); }
__device__ __forceinline__ unsigned xb_add(unsigned* p, unsigned v) { return __hip_atomic_fetch_add(p, v, __ATOMIC_RELAXED, __HIP_MEMORY_SCOPE_AGENT); }
__device__ __forceinline__ unsigned xb_xcc_id() { return (unsigned)__builtin_amdgcn_s_getreg((3 << 11) | 20) & 0xFu; }
#define XB_SPIN(cond, bar) do { unsigned _sp = 0; while (cond) { __builtin_amdgcn_s_sleep(1); \
    if ((++_sp & 255u) == 0u) { if (xb_ld(&(bar)[XB_TMO])) break; if (_sp > XB_SPIN_CAP) { atomicAdd(&(bar)[XB_TMO], 1u); break; } } } } while (0)

struct XcdBarrier {
    unsigned* bar; unsigned x;
    volatile LAS unsigned* st;
};

__device__ __forceinline__ XcdBarrier xcd_barrier_post(unsigned* bar, volatile LAS unsigned* st, const bool t0  ) {
    XcdBarrier b; b.bar = bar; b.x = xb_xcc_id(); b.st = st;
    if (t0) (void)xb_add(&bar[XB_XCNT(b.x)], 1u);
    return b;
}
__device__ __forceinline__ void xcd_barrier_complete(unsigned* bar, unsigned x, unsigned& nloc, unsigned& nx) {
    const unsigned G = gridDim.x * gridDim.y * gridDim.z;
    unsigned sum, cnt, mine, sp = 0u;
    for (;;) {
        sum = 0u; cnt = 0u; mine = 0u;
#pragma unroll
        for (unsigned j = 0; j < 16; ++j) { const unsigned c = xb_ld(&bar[XB_XCNT(j)]); sum += c; cnt += (c > 0u) ? 1u : 0u; mine = (j == x) ? c : mine; }
        if (sum == G) break;
        __builtin_amdgcn_s_sleep(1);
        if ((++sp & 255u) == 0u) { if (xb_ld(&bar[XB_TMO])) break; if (sp > XB_SPIN_CAP) { atomicAdd(&bar[XB_TMO], 1u); break; } }
    }
    nloc = mine > 0u ? mine : 1u; nx = cnt > 0u ? cnt : 1u;
}

__device__ __forceinline__ void xcd_barrier(const XcdBarrier& b, const bool t0  ) {
    asm volatile("s_waitcnt vmcnt(0)" ::: "memory");
    __syncthreads();
    if (t0) {
        unsigned* bar = b.bar;
        __builtin_amdgcn_s_waitcnt(0);
        unsigned nloc = b.st[0], nx = b.st[1];
        if (nloc == 0u) { xcd_barrier_complete(bar, b.x, nloc, nx); b.st[0] = nloc; b.st[1] = nx; }
        const unsigned old = xb_add(&bar[XB_XSUB(b.x)], 1u);
        const unsigned gen = old / nloc;
        if (old + 1u == (gen + 1u) * nloc) {
            __builtin_amdgcn_fence(__ATOMIC_RELEASE, "agent");
            asm volatile("s_waitcnt vmcnt(0)" ::: "memory");
            const unsigned og = xb_add(&bar[XB_TOP], 1u);
            const unsigned tg = og / nx;
            if (og + 1u == (tg + 1u) * nx) xb_add(&bar[XB_TOPGEN], 1u);
            else XB_SPIN(xb_ld(&bar[XB_TOPGEN]) == tg, bar);
            __builtin_amdgcn_fence(__ATOMIC_ACQUIRE, "agent");
            xb_add(&bar[XB_XGEN(b.x)], 1u);
            asm volatile("s_waitcnt vmcnt(0)" ::: "memory");
        } else {
            XB_SPIN(xb_ld(&bar[XB_XGEN(b.x)]) == gen, bar);
            __builtin_amdgcn_fence(__ATOMIC_ACQUIRE, "agent");
            asm volatile("s_waitcnt vmcnt(0)" ::: "memory");
        }
    }
    __syncthreads();
}


__device__ __forceinline__ float wave_sum(float v, int lane) {
#pragma unroll
    for (int o = 1; o < 64; o <<= 1) v += mk_shfl_xor(v, o, lane);
    return v;
}
__device__ __forceinline__ void sincos_d(double a, float& c_out, float& s_out) {
    const double TWO_PI = 6.283185307179586476925287;
    const double k = __builtin_rint(a / TWO_PI); double r = a - k * TWO_PI; r *= 0.25;
    const double r2 = r * r;
    double s = r * (1.0 + r2 * (-1.0 / 6 + r2 * (1.0 / 120 + r2 * (-1.0 / 5040 + r2 * (1.0 / 362880 + r2 * (-1.0 / 39916800 + r2 * (1.0 / 6227020800.0)))))));
    double c = 1.0 + r2 * (-0.5 + r2 * (1.0 / 24 + r2 * (-1.0 / 720 + r2 * (1.0 / 40320 + r2 * (-1.0 / 3628800 + r2 * (1.0 / 479001600.0 + r2 * (-1.0 / 87178291200.0)))))));
#pragma unroll
    for (int i = 0; i < 2; ++i) { const double s2 = 2.0 * s * c, c2 = c * c - s * s; s = s2; c = c2; }
    c_out = (float)c; s_out = (float)s;
}
__device__ __forceinline__ void row_to_bf16_rs(const float* xrow, bf16* orow, unsigned char* o8row, float* rs, int lane) {
    const GAS f32x4* xr = (const GAS f32x4*)xrow + lane;
    f32x4 v[8]; float s = 0.f;
#pragma unroll
    for (int j = 0; j < 8; ++j) { v[j] = xr[64 * j]; s += (v[j].x * v[j].x + v[j].y * v[j].y) + (v[j].z * v[j].z + v[j].w * v[j].w); }
    const float rstd = __builtin_amdgcn_rsqf(wave_sum(s, lane) * (1.f / DM) + RMS_EPS);
    GAS v2u* o8 = (GAS v2u*)orow + lane;
#pragma unroll
    for (int j = 0; j < 8; ++j) { v2u w; w.x = pk2(v[j].x, v[j].y); w.y = pk2(v[j].z, v[j].w); o8[64 * j] = w; ((GAS unsigned*)o8row + lane)[64 * j] = pk_fp8x4(v[j].x, v[j].y, v[j].z, v[j].w); }
    if (lane == 0) *rs = rstd;
}

__device__ __forceinline__ void norm_res_rows(bf16* Xb, unsigned char* X8, float* out_f32, const bf16* Fb, float* rs, const float* gpost, const bool deferred, const bool write_rs, const bool poison, const int gw, const int NGW, const int lane) {
    f32x4 gp[8];
#pragma unroll
    for (int j = 0; j < 8; ++j) gp[j] = *((const GAS f32x4*)gpost + lane + 64 * j);
    for (int m = gw; m < M; m += NGW) {
        const GAS v2u* fr = (const GAS v2u*)(Fb + (size_t)m * DM) + lane; GAS v2u* xb = (GAS v2u*)(Xb + (size_t)m * DM) + lane;
        f32x4 fv[8], xv[8]; float s = 0.f;
        float epsr = RMS_EPS;
        if (deferred) { const float r = *(const GAS float*)(rs + m); const float t = __builtin_amdgcn_rcpf(r * r); epsr = RMS_EPS * t * t; }
#pragma unroll
        for (int j = 0; j < 8; ++j) { const v2u xw = xb[64 * j]; xv[j] = (f32x4){bflo(xw.x), bfhi(xw.x), bflo(xw.y), bfhi(xw.y)}; }
#pragma unroll
        for (int j = 0; j < 8; ++j) { const v2u fw = fr[64 * j]; fv[j] = (f32x4){bflo(fw.x), bfhi(fw.x), bflo(fw.y), bfhi(fw.y)}; s += (fv[j].x * fv[j].x + fv[j].y * fv[j].y) + (fv[j].z * fv[j].z + fv[j].w * fv[j].w); }
        const float rf = __builtin_amdgcn_rsqf(wave_sum(s, lane) * (1.f / DM) + epsr);
        float s2 = 0.f;
#pragma unroll
        for (int j = 0; j < 8; ++j) { xv[j] = xv[j] + fv[j] * rf * gp[j]; s2 += (xv[j].x * xv[j].x + xv[j].y * xv[j].y) + (xv[j].z * xv[j].z + xv[j].w * xv[j].w); }
        if (out_f32) { GAS f32x4* xo = (GAS f32x4*)(out_f32 + (size_t)m * DM) + lane; const float qn = __builtin_nanf("");
#pragma unroll
            for (int j = 0; j < 8; ++j) xo[64 * j] = poison ? (f32x4){qn, qn, qn, qn} : xv[j]; }
        else {
#pragma unroll
            for (int j = 0; j < 8; ++j) { v2u w; w.x = pk2(xv[j].x, xv[j].y); w.y = pk2(xv[j].z, xv[j].w); xb[64 * j] = w; }
            if (X8) { GAS unsigned* x8 = (GAS unsigned*)(X8 + (size_t)m * DM) + lane;
#pragma unroll
                for (int j = 0; j < 8; ++j) x8[64 * j] = pk_fp8x4(xv[j].x, xv[j].y, xv[j].z, xv[j].w); } }
        if (write_rs) {
            const float rx = __builtin_amdgcn_rsqf(wave_sum(s2, lane) * (1.f / DM) + RMS_EPS);
            if (lane == 0) *(GAS float*)(rs + m) = rx;
        }
    }
}

struct Args { const float* in[15]; float* out; unsigned char* ws; int ph_lo, ph_hi; };
typedef const __attribute__((address_space(4))) Args* kargs_t;
__device__ __forceinline__ kargs_t kargs_() { kargs_t p = (kargs_t)__builtin_amdgcn_kernarg_segment_ptr(); asm volatile("" : "+s"(p)); return p; }
__device__ __forceinline__ int ltid_(int wave_s) { int t = wave_s * 64 + mk_lane(); asm volatile("" : "+v"(t)); return t; }
#define IN_F(k) ((const float*)(const GAS float*)ka->in[k])
#define PHASE_VARS() const kargs_t ka = kargs_(); unsigned char* ws = (unsigned char*)(GAS unsigned char*)ka->ws; int wave_ = wave_s; asm volatile("" : "+s"(wave_)); const int tid = ltid_(wave_s), lane = tid & 63, wave = wave_; \
    const int G = gridDim.x, bx = blockIdx.x, vcu = (G % 8 == 0) ? (bx % 8) * (G / 8) + bx / 8 : bx, gw = vcu * NWAVES + wave, NGW = G * NWAVES; (void)ws; (void)lane; (void)gw; (void)NGW; (void)ka

constexpr int CW_I_IN = (DM / 64) * (INW / 32), CW_I_SQ = (DM / 64) * (DM / 32), CW_I_UP = (DM / 64) * (DFF / 32), CW_I_DN = (DFF / 64) * (DM / 32), CW_I_LAYER = CW_I_IN + 3 * CW_I_SQ + CW_I_UP + CW_I_DN;
__device__ __forceinline__ void convert_weights(const kargs_t ka, unsigned char* ws, LAS float* scr, const int it_first, const int it_end, const int NGW, const int lane) {
    constexpr int I_IN = CW_I_IN, I_SQ = CW_I_SQ, I_UP = CW_I_UP, I_LAYER = CW_I_LAYER;
#define CW_DECODE(it_, src_, dst_, K_, N_, gs_, gf_, f8_) do { const int l_ = (it_) / I_LAYER; int r_ = (it_) % I_LAYER; unsigned char* wl_ = ws + WS_W + (size_t)l_ * W_LAYER; const float* W_; bf16* WT_; gs_ = IN_F(1) + (size_t)l_ * DM; gf_ = false; \
        if (r_ < I_IN) { W_ = IN_F(2) + (size_t)l_ * DM * INW; WT_ = (bf16*)(wl_ + W_IN); K_ = DM; N_ = INW; gf_ = true; } \
        else if ((r_ -= I_IN) < I_SQ) { W_ = IN_F(7) + (size_t)l_ * DM * DM; WT_ = (bf16*)(wl_ + W_OC); K_ = DM; N_ = DM; } \
        else if ((r_ -= I_SQ) < I_SQ) { W_ = IN_F(8) + (size_t)l_ * DM * DM; WT_ = (bf16*)(wl_ + W_OA); K_ = DM; N_ = DM; } \
        else if ((r_ -= I_SQ) < I_SQ) { W_ = IN_F(9) + (size_t)l_ * DM * DM; WT_ = (bf16*)(wl_ + W_MG); K_ = DM; N_ = DM; } \
        else if ((r_ -= I_SQ) < I_UP) { W_ = IN_F(12) + (size_t)l_ * DM * DFF; WT_ = (bf16*)(wl_ + W_UP); K_ = DM; N_ = DFF; gs_ = IN_F(11) + (size_t)l_ * DM; gf_ = true; } \
        else { r_ -= I_UP; W_ = IN_F(13) + (size_t)l_ * DFF * DM; WT_ = (bf16*)(wl_ + W_DN); K_ = DFF; N_ = DM; } \
        const int nblk_ = N_ / 32, k0_ = 64 * (r_ / nblk_), n0_ = 32 * (r_ % nblk_); int ns_ = n0_;     \
        if (N_ == INW && n0_ >= 2048 && n0_ < 6144) { const int q_ = n0_ - 2048, t_ = q_ >> 8, rr_ = q_ & 255; ns_ = ((rr_ >> 7) ? 4096 : 2048) + 128 * t_ + (rr_ & 127); } \
        const bool pf_ = (N_ == INW && n0_ >= 6144 && n0_ < 8704);     \
        if (pf_) { const int wc_ = (n0_ >> 5) & 3; ns_ = (n0_ & ~127) + 64 * (wc_ >> 1) + 16 * (wc_ & 1); } \
        const int q4_ = lane & 7, co_ = pf_ ? (32 * (q4_ & 1) + 4 * (q4_ >> 1)) : 4 * q4_; \
        gs_ += (k0_ % DM) + 8 * (lane & 7);     \
        f8_ = (N_ == INW && n0_ >= N_MAIN);     \
        src_ = W_ + (size_t)(k0_ + (lane >> 3)) * N_ + ns_ + co_; dst_ = (f8_) ? (bf16*)(wl_ + W_G8 + (size_t)(n0_ - N_MAIN) * K_ + k0_) : WT_ + (size_t)n0_ * K_ + k0_; } while (0)
#define CW_LOAD(S, idx_) do { S##ok = (idx_) < it_end; S##i = S##ok ? (idx_) : it_first; const float* s_; const float* gs_; bf16* d_; int K_, N_; bool gf_, f8_; CW_DECODE(S##i, s_, d_, K_, N_, gs_, gf_, f8_); (void)d_; (void)K_; \
        { const f32x4 a_ = *(const GAS f32x4*)(gs_), b_ = *((const GAS f32x4*)(gs_) + 1); const f32x4 one_ = {1.f, 1.f, 1.f, 1.f}; S##g[0] = gf_ ? a_ : one_; S##g[1] = gf_ ? b_ : one_; if (f8_) { S##g[0] *= G8_SCALE; S##g[1] *= G8_SCALE; } } \
        _Pragma("unroll") for (int j_ = 0; j_ < 8; ++j_) S##v[j_] = *(const GAS f32x4*)(s_ + (size_t)(8 * j_) * N_); } while (0)
#define CW_PROCESS(S) do { const float* s_; const float* gs_; bf16* S##d; int S##K, N_; bool gf_, S##f8; { int ix_ = S##i; asm volatile("" : "+s"(ix_)); CW_DECODE(ix_, s_, S##d, S##K, N_, gs_, gf_, S##f8); } (void)s_; (void)gs_; (void)N_; (void)gf_;     \
        { const int rw_ = (lane >> 3) * 33 + 4 * (lane & 7); \
            _Pragma("unroll") for (int j_ = 0; j_ < 8; ++j_) { scr[rw_ + j_ * 8 * 33 + 0] = S##v[j_].x; scr[rw_ + j_ * 8 * 33 + 1] = S##v[j_].y; scr[rw_ + j_ * 8 * 33 + 2] = S##v[j_].z; scr[rw_ + j_ * 8 * 33 + 3] = S##v[j_].w; } } \
        LDS_WAIT(); asm volatile("" ::: "memory"); const int c_ = lane & 7; \
        _Pragma("unroll") for (int j_ = 0; j_ < 4; ++j_) { const int n_ = (lane >> 3) + 8 * j_; const LAS float* sp_ = scr + (8 * c_) * 33 + n_; \
            const float e0_ = sp_[0 * 33] * S##g[0].x, e1_ = sp_[1 * 33] * S##g[0].y, e2_ = sp_[2 * 33] * S##g[0].z, e3_ = sp_[3 * 33] * S##g[0].w, e4_ = sp_[4 * 33] * S##g[1].x, e5_ = sp_[5 * 33] * S##g[1].y, e6_ = sp_[6 * 33] * S##g[1].z, e7_ = sp_[7 * 33] * S##g[1].w; \
            if (S##f8) { v2u o8_; o8_.x = pk_fp8x4(e0_, e1_, e2_, e3_); o8_.y = pk_fp8x4(e4_, e5_, e6_, e7_); *(GAS v2u*)((unsigned char*)(S##d) + (size_t)n_ * (S##K) + 8 * c_) = o8_; } \
            else { v4u o_; o_.x = pk2(e0_, e1_); o_.y = pk2(e2_, e3_); o_.z = pk2(e4_, e5_); o_.w = pk2(e6_, e7_); *(GAS v4u*)((S##d) + (size_t)n_ * (S##K) + 8 * c_) = o_; } } \
        LDS_WAIT(); asm volatile("" ::: "memory"); } while (0)
#define CW_SET(S) f32x4 S##v[8], S##g[2]; int S##i = 0; bool S##ok = false
    CW_SET(a); CW_SET(b); CW_SET(c);
    int it = it_first;
    CW_LOAD(a, it); CW_LOAD(b, it + NGW);
    for (;;) {
        CW_LOAD(c, it + 2 * NGW); if (!aok) break; CW_PROCESS(a);
        CW_LOAD(a, it + 3 * NGW); if (!bok) break; CW_PROCESS(b);
        CW_LOAD(b, it + 4 * NGW); if (!cok) break; CW_PROCESS(c);
        it += 3 * NGW;
    }
#undef CW_SET
#undef CW_PROCESS
#undef CW_LOAD
#undef CW_DECODE
}

__global__ void __launch_bounds__(NWAVES * 64, 2) fwd_kernel(Args args) {
    extern __shared__ __attribute__((aligned(16))) unsigned char lds_raw[];
    LAS unsigned char* lds = (LAS unsigned char*)lds_raw;
    const int wave_s = __builtin_amdgcn_readfirstlane((int)threadIdx.x >> 6);
    {   PHASE_VARS();
        volatile LAS unsigned* MISC = (volatile LAS unsigned*)(lds + MISC_OFF);
        for (int u = tid; u < (LDS_BYTES - LDSCTL_OFF) / 4; u += NWAVES * 64) ((LAS unsigned*)(lds + LDSCTL_OFF))[u] = 0u;
        __syncthreads();
        (void)xcd_barrier_post((unsigned*)(ws + WS_CTL) + CW_BAR, MISC + 8, tid == 0);
    }
#define GRID_BAR() do { XcdBarrier b_; b_.bar = (unsigned*)((unsigned char*)(GAS unsigned char*)kargs_()->ws + WS_CTL) + CW_BAR; unsigned x_ = xb_xcc_id(); asm volatile("" : "+s"(x_)); b_.x = x_; \
    b_.st = (volatile LAS unsigned*)(lds + MISC_OFF) + 8; xcd_barrier(b_, ltid_(wave_s) == 0); } while (0)

#if MK_PER_PHASE
    const int ph_lo = kargs_()->ph_lo, ph_hi = kargs_()->ph_hi;
#define IN(k) (ph_lo <= (k) && (k) < ph_hi)
#else
#define IN(k) true
#endif
#define SEAM(k) do { if (IN(k) && IN((k) + 1)) GRID_BAR(); } while (0)
    if (IN(0)) {   PHASE_VARS();
        convert_weights(ka, ws, (LAS float*)(lds + wave * 16384), gw, CW_I_LAYER, NGW, lane);
        {
            float* rope = (float*)(ws + WS_ROPE);
            const int gid = vcu * (NWAVES * 64) + tid;
            if (gid < 64 * 32) { const int pos = gid >> 5, f = gid & 31;
                double w = 1.0; const double c0 = 0.74989420933245582730218;
                for (int i = 0; i < f; ++i) w *= c0;
                const float wf = (float)w; const float ang = (float)pos * wf;
                float c, s; sincos_d((double)ang, c, s);
                rope[2 * gid] = c; rope[2 * gid + 1] = s; }
        }
        {   const float* x_in = IN_F(0); bf16* Xb = (bf16*)(ws + WS_X); float* rs = (float*)(ws + WS_RS);
            for (int m = gw; m < M; m += NGW) row_to_bf16_rs(x_in + (size_t)m * DM, Xb + (size_t)m * DM, ws + WS_H + (size_t)m * DM, rs + m, lane);
        }
    }
    SEAM(0);

    for (int l = 0; l < DEPTH; ++l) {
        const int pb = 1 + 9 * l;
        if (IN(pb + 0)) {   PHASE_VARS(); unsigned char* wl = ws + WS_W + (size_t)l * W_LAYER;
            pg8::Gemm g{(const bf16*)(ws + WS_X), (const bf16*)(wl + W_IN), M, N_MAIN, DM}; pg8::StaticOrder S; S.init(M, N_MAIN, G, bx, WGM_BIG);
            float m0;
            {   const float* qg_ = IN_F(5) + (size_t)l * HD; const float* kg_ = IN_F(6) + (size_t)l * HD;
                float gq_ = fmaxf(fabsf(qg_[lane]), fabsf(qg_[lane + 64])), gk_ = fmaxf(fabsf(kg_[lane]), fabsf(kg_[lane + 64]));
#pragma unroll
                for (int o_ = 1; o_ < 64; o_ <<= 1) { gq_ = fmaxf(gq_, mk_shfl_xor(gq_, o_, lane)); gk_ = fmaxf(gk_, mk_shfl_xor(gk_, o_, lane)); }
                m0 = __uint_as_float((unsigned)__builtin_amdgcn_readfirstlane((int)__float_as_uint(11.313708499f * gq_ * gk_))); }
            pg8::EpiZ E{(bf16*)(ws + WS_Z), ZW, (const float*)(ws + WS_RS), IN_F(5) + (size_t)l * HD, IN_F(6) + (size_t)l * HD, (const float*)(ws + WS_ROPE),
                        (m0 <= 40.f) ? att::SCALE * 1.4426950408889634f : 1.0f, RMS_EPS, lds + MISC_OFF + 64};
            pg8::gemm_phase<pg8::EpiZ, pg8::StaticOrder, PG8_ALIGN, PG8_SP2>(lds, g, S, E, wave_s);
            {   pg8::Gemm g8{(const bf16*)(ws + WS_H), (const bf16*)(wl + W_G8), M, N_GATE, DM}; pg8::StaticOrder S8; S8.init(M, N_GATE, G, bx, WGM_BIG);
                static_assert(ZW * 2 == 22528 && DM == 2048, "pitches hard-coded in EpiGateZ / EpiGate");
            pg8::EpiGateZ E8{ws + WS_Z + (size_t)Z_GA * 2, IN_F(3) + (size_t)l * 2 * DM, (const float*)(ws + WS_RS), 1.0f / G8_SCALE};
                pg8::gemm_phase<pg8::EpiGateZ, pg8::StaticOrder, PG8_ALIGN, PG8_SP2, true>(lds, g8, S8, E8, wave_s);
            }
        }
        SEAM(pb + 0);
        if (IN(pb + 2)) {   PHASE_VARS();
            bf16* Zb = (bf16*)(ws + WS_Z); bf16* Ob = (bf16*)(ws + WS_O);
            const int nunits = BATCH * NQH * (SEQ / 256), per = (nunits + G - 1) / G;
            float m0;
            {   const float* qg_ = IN_F(5) + (size_t)l * HD; const float* kg_ = IN_F(6) + (size_t)l * HD;
                float gq_ = fmaxf(fabsf(qg_[lane]), fabsf(qg_[lane + 64])), gk_ = fmaxf(fabsf(kg_[lane]), fabsf(kg_[lane + 64]));
#pragma unroll
                for (int o_ = 1; o_ < 64; o_ <<= 1) { gq_ = fmaxf(gq_, mk_shfl_xor(gq_, o_, lane)); gk_ = fmaxf(gk_, mk_shfl_xor(gk_, o_, lane)); }
                m0 = __uint_as_float((unsigned)__builtin_amdgcn_readfirstlane((int)__float_as_uint(11.313708499f * gq_ * gk_))); }
            const bool fixed_ok = (m0 <= 40.f); const float mCfix = -m0 * 1.4426950408889634f;
            for (int i = 0; i < per; ++i) {
                const int u = (G == 256) ? ((vcu >> 5) * 128 + (i >> 1) * 64 + (vcu & 31) * 2 + (i & 1)) : (vcu * per + i);
                if (u >= nunits) break;
                const int bk = u >> 6, b = bk >> 2, kvh = bk & 3, r = u & 63, gq = r >> 4, qb = r & 15, h = kvh * 4 + gq;
                const bf16* Qb = Zb + (size_t)(b * SEQ + qb * 256) * ZW + Z_Q + h * HD;
                const bf16* Kh = Zb + (size_t)(b * SEQ) * ZW + Z_K + kvh * HD;
                const bf16* Vh = Zb + (size_t)(b * SEQ) * ZW + Z_V + kvh * HD;
                bf16* Oo = Ob + (size_t)(b * SEQ + qb * 256) * DM + h * HD;
                if (fixed_ok) att::attn_unit<ZW, ZW, DM, true>(Qb, Kh, Vh, Oo, qb * 256, IN_F(5) + (size_t)l * HD, (const float*)(ws + WS_ROPE), SEQ, (LAS char*)lds, wave_s, mCfix);
                else          att::attn_unit<ZW, ZW, DM, false>(Qb, Kh, Vh, Oo, qb * 256, IN_F(5) + (size_t)l * HD, (const float*)(ws + WS_ROPE), SEQ, (LAS char*)lds, wave_s, 0.f);
                if (l + 1 < DEPTH && i == ((vcu >> 3) % per)) {
                    __syncthreads();
                    const int wv_ = __builtin_amdgcn_readfirstlane(ltid_(wave_s) >> 6);
                    convert_weights(ka, ws, (LAS float*)(lds + wv_ * 16384), (l + 1) * CW_I_LAYER + gw, (l + 2) * CW_I_LAYER, NGW, ltid_(wave_s) & 63);
                    __syncthreads();
                }
            }
            bf16* CAb = (bf16*)(ws + WS_CA);
            {
            const float* cw = IN_F(4) + (size_t)l * 3 * DM;
            const int half = tid >> 8, c0 = (tid & 255) * 8;
            float w0[8], w1[8], w2[8];
#pragma unroll
            for (int e = 0; e < 8; ++e) { w0[e] = cw[c0 + e]; w1[e] = cw[DM + c0 + e]; w2[e] = cw[2 * DM + c0 + e]; }
            for (int unit = vcu; unit < M / 64; unit += G) {
                const int r0 = unit * 64 + half * 32;
                const bf16* zc = Zb + (size_t)r0 * ZW + c0;
                float up[8], uc[8], un[8];
                {   const bool hp = (r0 % SEQ) != 0;
                    const v4u a = *(const GAS v4u*)(zc + Z_U - (hp ? ZW : 0));
                    const float sc = hp ? 1.f : 0.f;
                    up[0] = bflo(a.x) * sc; up[1] = bfhi(a.x) * sc; up[2] = bflo(a.y) * sc; up[3] = bfhi(a.y) * sc; up[4] = bflo(a.z) * sc; up[5] = bfhi(a.z) * sc; up[6] = bflo(a.w) * sc; up[7] = bfhi(a.w) * sc; }
                {   const v4u a = *(const GAS v4u*)(zc + Z_U);
                    uc[0] = bflo(a.x); uc[1] = bfhi(a.x); uc[2] = bflo(a.y); uc[3] = bfhi(a.y); uc[4] = bflo(a.z); uc[5] = bfhi(a.z); uc[6] = bflo(a.w); uc[7] = bfhi(a.w); }
#pragma unroll 4
                for (int i = 0; i < 32; ++i) {
                    const int r = r0 + i; const bool hn = ((r + 1) % SEQ) != 0;
                    const bf16* zr = zc + (size_t)i * ZW;
                    const v4u a = *(const GAS v4u*)(zr + Z_U + (hn ? ZW : 0)), cb = *(const GAS v4u*)(zr + Z_CB);
                    const float sc = hn ? 1.f : 0.f;
                    un[0] = bflo(a.x) * sc; un[1] = bfhi(a.x) * sc; un[2] = bflo(a.y) * sc; un[3] = bfhi(a.y) * sc; un[4] = bflo(a.z) * sc; un[5] = bfhi(a.z) * sc; un[6] = bflo(a.w) * sc; un[7] = bfhi(a.w) * sc;
                    const float cbf[8] = {bflo(cb.x), bfhi(cb.x), bflo(cb.y), bfhi(cb.y), bflo(cb.z), bfhi(cb.z), bflo(cb.w), bfhi(cb.w)};
                    float o[8];
#pragma unroll
                    for (int e = 0; e < 8; ++e) { o[e] = cbf[e] * (w0[e] * up[e] + w1[e] * uc[e] + w2[e] * un[e]); up[e] = uc[e]; uc[e] = un[e]; }
                    v4u w; w.x = pk2(o[0], o[1]); w.y = pk2(o[2], o[3]); w.z = pk2(o[4], o[5]); w.w = pk2(o[6], o[7]);
                    *(GAS v4u*)(CAb + (size_t)r * DM + c0) = w;
                }
            }
            }
            __syncthreads();
        }
        SEAM(pb + 2);
        if (IN(pb + 3)) {   PHASE_VARS(); unsigned char* wl = ws + WS_W + (size_t)l * W_LAYER;
            pg8::Gemm g{(const bf16*)(ws + WS_CA), (const bf16*)(wl + W_OC), M, DM, DM}; pg8::DualOrder S; S.init(M, DM, G, bx, WGM_SQ); S.A2 = (const bf16*)(ws + WS_O); S.Bt2 = (const bf16*)(wl + W_OA);
            pg8::EpiGateDual E{(bf16*)(ws + WS_G), ws + WS_Z + (size_t)Z_GA * 2};
            pg8::gemm_phase<pg8::EpiGateDual, pg8::DualOrder, PG8_ALIGN, PG8_SP2>(lds, g, S, E, wave_s);
        }
        SEAM(pb + 3);
        if (IN(pb + 4)) {   PHASE_VARS(); unsigned char* wl = ws + WS_W + (size_t)l * W_LAYER;
            pg8::Gemm g{(const bf16*)(ws + WS_G), (const bf16*)(wl + W_MG), M, DM, DM}; pg8::StaticOrder S; S.init(M, DM, G, bx, WGM_SQ);
            pg8::EpiBf16<0> E{(bf16*)(ws + WS_F), DM};
            pg8::gemm_phase<pg8::EpiBf16<0>, pg8::StaticOrder, PG8_ALIGN, PG8_SP2>(lds, g, S, E, wave_s);
        }
        SEAM(pb + 4);
        if (IN(pb + 5)) {   PHASE_VARS();
            norm_res_rows((bf16*)(ws + WS_X), nullptr, nullptr, (const bf16*)(ws + WS_F), (float*)(ws + WS_RS), IN_F(10) + (size_t)l * DM, false, true, false, gw, NGW, lane);
        }
        SEAM(pb + 5);
        if (IN(pb + 6)) {   PHASE_VARS(); unsigned char* wl = ws + WS_W + (size_t)l * W_LAYER;
            pg8::Gemm g{(const bf16*)(ws + WS_X), (const bf16*)(wl + W_UP), M, DFF, DM}; pg8::StaticOrder S; S.init(M, DFF, G, bx, WGM_BIG);
            pg8::EpiBf16<1> E{(bf16*)(ws + WS_Z), DFF};
            pg8::gemm_phase<pg8::EpiBf16<1>, pg8::StaticOrder, PG8_ALIGN, PG8_SP2>(lds, g, S, E, wave_s);
        }
        SEAM(pb + 6);
        if (IN(pb + 7)) {   PHASE_VARS(); unsigned char* wl = ws + WS_W + (size_t)l * W_LAYER;
            pg8::Gemm g{(const bf16*)(ws + WS_Z), (const bf16*)(wl + W_DN), M, DM, DFF}; pg8::StaticOrder S; S.init(M, DM, G, bx, 4);
            pg8::EpiBf16<0> E{(bf16*)(ws + WS_F), DM};
            pg8::gemm_phase<pg8::EpiBf16<0>, pg8::StaticOrder, PG8_ALIGN, PG8_SP2>(lds, g, S, E, wave_s);
        }
        SEAM(pb + 7);
        if (IN(pb + 8)) {   PHASE_VARS();
            const bool more = (l + 1 < DEPTH);
            const bool poison = !more && (__hip_atomic_load((unsigned*)(ws + WS_CTL) + CW_BAR + XB_TMO, __ATOMIC_RELAXED, __HIP_MEMORY_SCOPE_AGENT) != 0u);
            norm_res_rows((bf16*)(ws + WS_X), more ? ws + WS_H : nullptr, more ? nullptr : (float*)(GAS float*)ka->out, (const bf16*)(ws + WS_F), (float*)(ws + WS_RS), IN_F(14) + (size_t)l * DM, true, more, poison, gw, NGW, lane);
        }
        if (l + 1 < DEPTH) SEAM(pb + 8);
    }
}


extern "C" void kernel_launch(void* const* d_in, const int* in_sizes, int n_in, void* d_out, int out_size, void* d_ws, size_t ws_size, hipStream_t stream) {
    static int grid = 0;
    if (grid == 0) {
        if (n_in != 15 || in_sizes[0] != M * DM || out_size != M * DM || ws_size < WS_END) {
            fprintf(stderr, "kernel_launch: built for 15 inputs, x/out of %d floats, >= %zu bytes of workspace; got n_in %d, in0 %d, out %d, ws %zu; nothing launched\n", M * DM, (size_t)WS_END, n_in, n_in > 0 ? in_sizes[0] : -1, out_size, ws_size);
            grid = -1; return; }
        int dev = 0, cus = 0, per_cu = 0;
        if (hipGetDevice(&dev) != hipSuccess || hipDeviceGetAttribute(&cus, hipDeviceAttributeMultiprocessorCount, dev) != hipSuccess) { fprintf(stderr, "kernel_launch: device query failed\n"); grid = -1; return; }
        if (hipFuncSetAttribute((const void*)fwd_kernel, hipFuncAttributeMaxDynamicSharedMemorySize, LDS_BYTES) != hipSuccess) { fprintf(stderr, "kernel_launch: hipFuncSetAttribute failed\n"); grid = -1; return; }
        if (hipOccupancyMaxActiveBlocksPerMultiprocessor(&per_cu, (const void*)fwd_kernel, NWAVES * 64, LDS_BYTES) != hipSuccess || per_cu < 1)
            fprintf(stderr, "kernel_launch: note: occupancy query reports %d workgroups per CU\n", per_cu);
        (void)hipGetLastError();
        grid = cus;
    }
    if (grid < 0) return;
    if (hipMemsetAsync((char*)d_ws + WS_CTL, 0, CTL_ZERO_BYTES, stream) != hipSuccess) { fprintf(stderr, "kernel_launch: hipMemsetAsync failed\n"); return; }
    Args a{};
    for (int i = 0; i < 15; ++i) a.in[i] = (const float*)d_in[i];
    a.out = (float*)d_out; a.ws = (unsigned char*)d_ws;
    constexpr int NPHASES = 1 + 9 * DEPTH;
    if (MK_PER_PHASE) { for (int p = 0; p < NPHASES; ++p) { a.ph_lo = p; a.ph_hi = p + 1; hipLaunchKernelGGL(fwd_kernel, dim3(grid), dim3(NWAVES * 64), LDS_BYTES, stream, a); } }
    else { a.ph_lo = 0; a.ph_hi = NPHASES; hipLaunchKernelGGL(fwd_kernel, dim3(grid), dim3(NWAVES * 64), LDS_BYTES, stream, a); }
    const hipError_t le = hipPeekAtLastError();
    if (le != hipSuccess) fprintf(stderr, "kernel_launch: launch failed: %s\n", hipGetErrorName(le));
}
```

```cpp
#include <hip/hip_runtime.h>
#include <cstdio>
#include <cstdint>

__device__ __forceinline__ int mk_lane() { int l; asm volatile("v_mbcnt_lo_u32_b32 %0, -1, 0\n\tv_mbcnt_hi_u32_b32 %0, -1, %0" : "=v"(l)); return l; }
__device__ __forceinline__ float mk_shfl_xor(float v, int mask, int lane) { return __builtin_bit_cast(float, __builtin_amdgcn_ds_bpermute((lane ^ mask) << 2, __builtin_bit_cast(int, v))); }
#ifndef PG8_RELAX
#define PG8_RELAX 1
#endif
namespace pg8 {
#define PG8_LAS __attribute__((address_space(3)))
typedef unsigned short bf16_t;
typedef short bf16x8 __attribute__((ext_vector_type(8)));
typedef float f32x4 __attribute__((ext_vector_type(4)));
typedef unsigned u32x4 __attribute__((ext_vector_type(4)));
typedef int v8i32 __attribute__((ext_vector_type(8)));
constexpr int BM = 256, BK = 64, HALF = 128, HTB = HALF * BK * 2  , STAGE_BYTES = 8 * HTB, NXCD = 8, WGM = 8;

__host__ __device__ __forceinline__ int lds_byte(int r, int c) { const int st = (r >> 4) * 2 + (c >> 5), rr = r & 15, cc = c & 31, ob = rr * 64 + cc * 2; return st * 1024 + (ob ^ (((ob >> 9) & 1) << 5)); }
__host__ __device__ __forceinline__ void stage_rc(int b, int& R, int& C) { const int st = b / 1024, sb = b % 1024, swz = sb ^ (((sb >> 9) & 1) << 5); R = (st >> 1) * 16 + swz / 64; C = (st & 1) * 32 + (swz % 64) / 2; }
__host__ __device__ __forceinline__ int perm32(int rho) { const int n = rho >> 4, i = rho & 15; return 8 * (i >> 2) + 4 * n + (i & 3); }

struct Unit { int pm, pn; };
struct Gemm { const bf16_t* A; const bf16_t* Bt; int M, N, K; };

struct StaticOrder {
    int nM, nN, nwg, G, c, wgm;
    __host__ __device__ void init(int M, int N, int G_, int c_, int wgm_ = WGM) { nM = M / BM; nN = N / BM; nwg = nM * nN; G = G_; c = c_; wgm = wgm_; }
    __host__ __device__ bool next(int i, Unit& u) const {
        const long L = (long)i * G + c; if (L >= nwg) return false;
        int wgid = (int)L; { const int q = nwg / NXCD, r = nwg % NXCD, xcd = wgid % NXCD, off = wgid / NXCD; wgid = (xcd < r ? xcd * (q + 1) : r * (q + 1) + (xcd - r) * q) + off; }
        const int nig = wgm * nN, gid = wgid / nig, fm = gid * wgm, gsz = (nM - fm) < wgm ? (nM - fm) : wgm;
        u.pm = fm + ((wgid % nig) % gsz); u.pn = (wgid % nig) / gsz; return true;
    }
    static constexpr bool DUAL = false;
    __device__ __forceinline__ const char* opA2() const { return nullptr; }
    __device__ __forceinline__ const char* opB2() const { return nullptr; }
    __device__ __forceinline__ void a_ready(const Unit&) const {}
    __device__ __forceinline__ void done(const Unit&) const {}
};
struct DualOrder : StaticOrder {
    const bf16_t* A2; const bf16_t* Bt2;
    static constexpr bool DUAL = true;
    __device__ __forceinline__ const char* opA2() const { return (const char*)A2; }
    __device__ __forceinline__ const char* opB2() const { return (const char*)Bt2; }
};


#ifndef PG8_NT_STORES
#define PG8_NT_STORES 0
#endif
#if PG8_NT_STORES
#define PG8_ST16(p, v) __builtin_nontemporal_store((v), (u32x4*)(p))
#else
#define PG8_ST16(p, v) (*(u32x4*)(p) = (v))
#endif
typedef float f32x2_t __attribute__((ext_vector_type(2)));
typedef __bf16 bf16x2_t __attribute__((ext_vector_type(2)));
__device__ __forceinline__ unsigned cvt_pk_bf16(float lo, float hi) { const f32x2_t v = {lo, hi}; const bf16x2_t b = __builtin_convertvector(v, bf16x2_t); return __builtin_bit_cast(unsigned, b); }
__device__ __forceinline__ float bf_lo(unsigned w) { return __uint_as_float(w << 16); }
__device__ __forceinline__ float bf_hi(unsigned w) { return __uint_as_float(w & 0xffff0000u); }
__device__ __forceinline__ float sigmoid_f(float x) { return __builtin_amdgcn_rcpf(1.0f + __builtin_amdgcn_exp2f(-1.4426950408889634f * x)); }
__device__ __forceinline__ u32x4 pack8(const f32x4 v0, const f32x4 v1) { u32x4 w; w.x = cvt_pk_bf16(v0[0], v0[1]); w.y = cvt_pk_bf16(v0[2], v0[3]); w.z = cvt_pk_bf16(v1[0], v1[1]); w.w = cvt_pk_bf16(v1[2], v1[3]); return w; }

struct EpiZ {
    static constexpr bool PERM = true, AFTER_DRAIN = false, LV = false; static constexpr int NST = 8;
    bf16_t* O; int ldc; const float* rs; const float* qg; const float* kg; const float* rope; float qscale; float eps; PG8_LAS unsigned char* misc;
    __device__ __forceinline__ void operator()(const f32x4 (&acc)[2][2][4][2], const Unit& u, int wr_, int wc_, int, int) const {
        int wr = wr_, wc = wc_; asm volatile("" : "+s"(wr), "+s"(wc));
        const int lane_ = mk_lane(), fr = lane_ & 15, fq = lane_ >> 4;
        const int row0 = u.pm * BM + wr * 64 + fr, gcol0 = u.pn * BM + wc * 32 + 8 * fq;
        float rv[2][4];
#pragma unroll
        for (int ai = 0; ai < 2; ++ai)
#pragma unroll
            for (int m = 0; m < 4; ++m) rv[ai][m] = rs[row0 + ai * HALF + m * 16];
        if (u.pn >= 8 && u.pn < 24) {
            const int col0 = 2048 + HALF * (u.pn - 8) + wc * 32 + 8 * fq;
#pragma unroll
            for (int ai = 0; ai < 2; ++ai)
#pragma unroll
                for (int m = 0; m < 4; ++m) { const float r2 = rv[ai][m] * rv[ai][m]; PG8_ST16(O + (size_t)(row0 + ai * HALF + m * 16) * ldc + col0, pack8(acc[ai][0][m][0] * acc[ai][1][m][0] * r2, acc[ai][0][m][1] * acc[ai][1][m][1] * r2)); }
        } else if (u.pn >= 24 && u.pn < 34) {
            const bool isq = u.pn < 32; const float* gn = isq ? qg : kg;
            const int ax = wc >> 1, f0 = 16 * (wc & 1) + 4 * fq, d1 = 64 * ax + f0;
            const f32x4 g1 = *(const f32x4*)(gn + d1), g2 = *(const f32x4*)(gn + d1 + 32);
            PG8_LAS float* PARTf = (PG8_LAS float*)misc; const PG8_LAS f32x4* PART4 = (const PG8_LAS f32x4*)misc;
#pragma unroll
            for (int ai = 0; ai < 2; ++ai)
#pragma unroll
                for (int bj = 0; bj < 2; ++bj) { float sq[4];
#pragma unroll
                    for (int m = 0; m < 4; ++m) { const f32x4 v0 = acc[ai][bj][m][0], v1 = acc[ai][bj][m][1]; sq[m] = ((v0[0] * v0[0] + v0[1] * v0[1]) + (v0[2] * v0[2] + v0[3] * v0[3])) + ((v1[0] * v1[0] + v1[1] * v1[1]) + (v1[2] * v1[2] + v1[3] * v1[3])); }
                    auto r02 = __builtin_amdgcn_permlane32_swap(__float_as_uint(sq[0]), __float_as_uint(sq[2]), false, false); const float w0 = __uint_as_float(r02[0]) + __uint_as_float(r02[1]);
                    auto r13 = __builtin_amdgcn_permlane32_swap(__float_as_uint(sq[1]), __float_as_uint(sq[3]), false, false); const float w1 = __uint_as_float(r13[0]) + __uint_as_float(r13[1]);
                    auto rr = __builtin_amdgcn_permlane16_swap(__float_as_uint(w0), __float_as_uint(w1), false, false); const float tw = __uint_as_float(rr[0]) + __uint_as_float(rr[1]);
                    PARTf[((((wr * 2 + ai) * 2 + bj) * 64) + (fq * 16 + fr)) * 4 + wc] = tw; }
            asm volatile("s_waitcnt lgkmcnt(0)" ::: "memory"); __builtin_amdgcn_s_barrier(); asm volatile("" ::: "memory");
            const int colh = u.pn * BM - 2048 + d1;
#pragma unroll
            for (int ai = 0; ai < 2; ++ai)
#pragma unroll
                for (int m = 0; m < 4; ++m) { const int row = row0 + ai * HALF + m * 16, t = row & 4095, pos = ax ? (t & 63) : (t >> 6);
                    const f32x4 csa = *(const f32x4*)(rope + (size_t)(pos * 32 + f0) * 2), csb = *(const f32x4*)(rope + (size_t)(pos * 32 + f0) * 2 + 4);
                    const f32x4 cc = {csa[0], csa[2], csb[0], csb[2]}, sn = {csa[1], csa[3], csb[1], csb[3]};
                    const float r = rv[ai][m]; const float epsr = eps * __builtin_amdgcn_rcpf(r * r);
                    bf16_t* rowp = O + (size_t)row * ldc + colh;
#pragma unroll
                    for (int bj = 0; bj < 2; ++bj) { const f32x4 pp = PART4[((wr * 2 + ai) * 2 + bj) * 64 + m * 16 + fr];
                        const float rstd = __builtin_amdgcn_rsqf(((pp[0] + pp[1]) + (pp[2] + pp[3])) * (1.0f / 128.0f) + epsr) * (isq ? qscale : 1.0f);
                        const f32x4 x1 = acc[ai][bj][m][0] * g1 * rstd, x2 = acc[ai][bj][m][1] * g2 * rstd;
                        const f32x4 o1 = x1 * cc - x2 * sn, o2 = x2 * cc + x1 * sn;
                        typedef unsigned u32x2v __attribute__((ext_vector_type(2)));
                        u32x2v wa, wb; wa.x = cvt_pk_bf16(o1[0], o1[1]); wa.y = cvt_pk_bf16(o1[2], o1[3]); wb.x = cvt_pk_bf16(o2[0], o2[1]); wb.y = cvt_pk_bf16(o2[2], o2[3]);
                        *(u32x2v*)(rowp + bj * HALF) = wa; *(u32x2v*)(rowp + bj * HALF + 32) = wb; } }
        } else {
            const int col0 = gcol0 - (u.pn >= 24 ? 2048 : 0);
#pragma unroll
            for (int ai = 0; ai < 2; ++ai)
#pragma unroll
                for (int m = 0; m < 4; ++m) { bf16_t* rowp = O + (size_t)(row0 + ai * HALF + m * 16) * ldc + col0;
#pragma unroll
                    for (int bj = 0; bj < 2; ++bj) PG8_ST16(rowp + bj * HALF, pack8(acc[ai][bj][m][0] * rv[ai][m], acc[ai][bj][m][1] * rv[ai][m])); }
        }
    }
};
struct EpiGateZ {
    static constexpr bool PERM = true, AFTER_DRAIN = false, LV = false; static constexpr int NST = 16;
    static constexpr int ldc = 22528;
    unsigned char* O; const float* bias; const float* rs; float wsc;
    static __device__ __forceinline__ unsigned pk_u8x4(const f32x4 v) { unsigned w = 0u;
        w = __builtin_amdgcn_cvt_pk_u8_f32(fmaxf(__builtin_rintf(v[0] * 255.0f), 1.0f), 0u, w); w = __builtin_amdgcn_cvt_pk_u8_f32(fmaxf(__builtin_rintf(v[1] * 255.0f), 1.0f), 1u, w);
        w = __builtin_amdgcn_cvt_pk_u8_f32(fmaxf(__builtin_rintf(v[2] * 255.0f), 1.0f), 2u, w); w = __builtin_amdgcn_cvt_pk_u8_f32(fmaxf(__builtin_rintf(v[3] * 255.0f), 1.0f), 3u, w); return w; }
    __device__ __forceinline__ void operator()(const f32x4 (&acc)[2][2][4][2], const Unit& u, int wr_, int wc_, int, int) const {
        typedef unsigned u32x2v __attribute__((ext_vector_type(2)));
        int wr = wr_, wc = wc_; asm volatile("" : "+s"(wr), "+s"(wc));
        const int lane_ = mk_lane(), fr = lane_ & 15, fq = lane_ >> 4;
        const int row0 = u.pm * BM + wr * 64 + fr, col0 = u.pn * BM + wc * 32 + 8 * fq;
        float rvz[2][4];
#pragma unroll
        for (int ai = 0; ai < 2; ++ai)
#pragma unroll
            for (int m = 0; m < 4; ++m) rvz[ai][m] = rs[row0 + ai * HALF + m * 16];
        f32x4 bv[2][2];
#pragma unroll
        for (int bj = 0; bj < 2; ++bj)
#pragma unroll
            for (int n = 0; n < 2; ++n) bv[bj][n] = *(const f32x4*)(bias + col0 + bj * HALF + 4 * n) * -1.4426950408889634f;
        __builtin_amdgcn_sched_barrier(0);
#pragma unroll
        for (int ai = 0; ai < 2; ++ai)
#pragma unroll
            for (int m = 0; m < 4; ++m) { const float r = rvz[ai][m] * (wsc * -1.4426950408889634f); unsigned char* rowp = O + (size_t)(row0 + ai * HALF + m * 16) * ldc + col0;
#pragma unroll
                for (int bj = 0; bj < 2; ++bj) { f32x4 v0 = acc[ai][bj][m][0] * r + bv[bj][0], v1 = acc[ai][bj][m][1] * r + bv[bj][1];
#pragma unroll
                    for (int e = 0; e < 4; ++e) { v0[e] = __builtin_amdgcn_rcpf(1.0f + __builtin_amdgcn_exp2f(v0[e])); v1[e] = __builtin_amdgcn_rcpf(1.0f + __builtin_amdgcn_exp2f(v1[e])); }
                    u32x2v w; w.x = pk_u8x4(v0); w.y = pk_u8x4(v1); *(u32x2v*)(rowp + bj * HALF) = w; } }
    }
};
template <int ACT> struct EpiBf16 {
    static constexpr bool PERM = true, AFTER_DRAIN = false, LV = (ACT == 0);     static constexpr int NST = 16;
    bf16_t* O; int ldc;
    __device__ __forceinline__ void operator()(const f32x4 (&acc)[2][2][4][2], const Unit& u, int wr, int wc, int fr, int fq) const {
        const int row0 = u.pm * BM + wr * 64 + fr, col0 = u.pn * BM + wc * 32 + 8 * fq;
#pragma unroll
        for (int ai = 0; ai < 2; ++ai)
#pragma unroll
            for (int m = 0; m < 4; ++m) { bf16_t* rowp = O + (size_t)(row0 + ai * HALF + m * 16) * ldc + col0;
#pragma unroll
                for (int bj = 0; bj < 2; ++bj) { f32x4 v0 = acc[ai][bj][m][0], v1 = acc[ai][bj][m][1];
                    if (ACT == 1) {
#pragma unroll
                        for (int e = 0; e < 4; ++e) { const float a = __builtin_amdgcn_fmed3f(v0[e], 0.f, __builtin_inff()), b = __builtin_amdgcn_fmed3f(v1[e], 0.f, __builtin_inff()); v0[e] = a * a; v1[e] = b * b; } }
                    PG8_ST16(rowp + bj * HALF, pack8(v0, v1)); } }
    }
};
template <int MODE> struct EpiGate {
    static constexpr bool PERM = true, AFTER_DRAIN = false, LV = false; static constexpr int NST = 16;
    static constexpr int ldc = 2048, ldg = 22528;
    bf16_t* O; const unsigned char* Zg; const bf16_t* P;
    __device__ __forceinline__ void operator()(const f32x4 (&acc)[2][2][4][2], const Unit& u, int wr, int wc, int fr, int fq) const {
        const int row0 = u.pm * BM + wr * 64 + fr, col0 = u.pn * BM + wc * 32 + 8 * fq;
#pragma unroll
        for (int ai = 0; ai < 2; ++ai)
#pragma unroll
            for (int m = 0; m < 4; ++m) { const size_t r = (size_t)(row0 + ai * HALF + m * 16);
#pragma unroll
                for (int bj = 0; bj < 2; ++bj) {
                    typedef unsigned u32x2v __attribute__((ext_vector_type(2)));
                    const u32x2v g = *(const u32x2v*)(Zg + r * ldg + col0 + bj * HALF); constexpr float q = 1.0f / 255.0f;
                    f32x4 v0 = acc[ai][bj][m][0] * ((f32x4){(float)(g.x & 255u), (float)((g.x >> 8) & 255u), (float)((g.x >> 16) & 255u), (float)(g.x >> 24)} * q);
                    f32x4 v1 = acc[ai][bj][m][1] * ((f32x4){(float)(g.y & 255u), (float)((g.y >> 8) & 255u), (float)((g.y >> 16) & 255u), (float)(g.y >> 24)} * q);
                    if (MODE == 1) { const u32x4 p = *(const u32x4*)(P + r * ldc + col0 + bj * HALF);
                        v0 += (f32x4){bf_lo(p.x), bf_hi(p.x), bf_lo(p.y), bf_hi(p.y)}; v1 += (f32x4){bf_lo(p.z), bf_hi(p.z), bf_lo(p.w), bf_hi(p.w)}; }
                    PG8_ST16(O + r * ldc + col0 + bj * HALF, pack8(v0, v1)); } }
    }
};
struct EpiGateDual {
    static constexpr bool PERM = true, AFTER_DRAIN = false, LV = false; static constexpr int NST = 16;
    static constexpr int ldc = 2048, ldg = 22528, gboff = 2048;
    bf16_t* O; const unsigned char* Zg;
#define EGD_U8(w) (f32x4){(float)((w) & 255u), (float)(((w) >> 8) & 255u), (float)(((w) >> 16) & 255u), (float)((w) >> 24)}
    __device__ __forceinline__ void mid(f32x4 (&acc)[2][2][4][2], const Unit& u, int wr, int wc, int fr, int fq) const {
        typedef unsigned u32x2v __attribute__((ext_vector_type(2)));
        const int row0 = u.pm * BM + wr * 64 + fr, col0 = u.pn * BM + wc * 32 + 8 * fq;
        u32x2v ga[2][4][2], gb[2][4][2];
#pragma unroll
        for (int ai = 0; ai < 2; ++ai)
#pragma unroll
            for (int m = 0; m < 4; ++m)
#pragma unroll
                for (int bj = 0; bj < 2; ++bj) { const unsigned char* gp = Zg + (size_t)(row0 + ai * HALF + m * 16) * ldg + col0 + bj * HALF;
                    ga[ai][m][bj] = *(const u32x2v*)gp; gb[ai][m][bj] = *(const u32x2v*)(gp + gboff); }
        __builtin_amdgcn_sched_barrier(0);
#pragma unroll
        for (int ai = 0; ai < 2; ++ai)
#pragma unroll
            for (int m = 0; m < 4; ++m)
#pragma unroll
                for (int bj = 0; bj < 2; ++bj) {
                    const f32x4 b0 = EGD_U8(gb[ai][m][bj].x), b1 = EGD_U8(gb[ai][m][bj].y);
                    const f32x4 r0 = {__builtin_amdgcn_rcpf(b0[0]), __builtin_amdgcn_rcpf(b0[1]), __builtin_amdgcn_rcpf(b0[2]), __builtin_amdgcn_rcpf(b0[3])}, r1 = {__builtin_amdgcn_rcpf(b1[0]), __builtin_amdgcn_rcpf(b1[1]), __builtin_amdgcn_rcpf(b1[2]), __builtin_amdgcn_rcpf(b1[3])};
                    acc[ai][bj][m][0] = acc[ai][bj][m][0] * (EGD_U8(ga[ai][m][bj].x) * r0); acc[ai][bj][m][1] = acc[ai][bj][m][1] * (EGD_U8(ga[ai][m][bj].y) * r1); }
    }
    __device__ __forceinline__ void operator()(const f32x4 (&acc)[2][2][4][2], const Unit& u, int wr, int wc, int fr, int fq) const {
        typedef unsigned u32x2v __attribute__((ext_vector_type(2)));
        const int row0 = u.pm * BM + wr * 64 + fr, col0 = u.pn * BM + wc * 32 + 8 * fq; constexpr float q = 1.0f / 255.0f;
#pragma unroll
        for (int ai = 0; ai < 2; ++ai)
#pragma unroll
            for (int m = 0; m < 4; ++m) { const size_t r = (size_t)(row0 + ai * HALF + m * 16);
#pragma unroll
                for (int bj = 0; bj < 2; ++bj) { const u32x2v gb = *(const u32x2v*)(Zg + r * ldg + gboff + col0 + bj * HALF);
                    const f32x4 v0 = acc[ai][bj][m][0] * (EGD_U8(gb.x) * q), v1 = acc[ai][bj][m][1] * (EGD_U8(gb.y) * q);
                    PG8_ST16(O + r * ldc + col0 + bj * HALF, pack8(v0, v1)); } }
    }
#undef EGD_U8
};
struct EpiF32 {
    static constexpr bool PERM = false, AFTER_DRAIN = false, LV = false; static constexpr int NST = 32;
    float* O; int ldc;
    __device__ __forceinline__ void operator()(const f32x4 (&acc)[2][2][4][2], const Unit& u, int wr, int wc, int fr, int fq) const {
        const int row0 = u.pm * BM + wr * 64 + fr, col0 = u.pn * BM + wc * 32 + 4 * fq;
#pragma unroll
        for (int ai = 0; ai < 2; ++ai)
#pragma unroll
            for (int m = 0; m < 4; ++m) { float* rowp = O + (size_t)(row0 + ai * HALF + m * 16) * ldc + col0;
#pragma unroll
                for (int bj = 0; bj < 2; ++bj)
#pragma unroll
                    for (int n = 0; n < 2; ++n) *(f32x4*)(rowp + bj * HALF + n * 16) = acc[ai][bj][m][n]; }
    }
};

__device__ __forceinline__ void glds16_asm(const void* sbase  , unsigned voff, unsigned lds_dst) { unsigned keep;
    asm volatile("s_mov_b32 %0, m0\n\ts_mov_b32 m0, %3\n\ts_nop 0\n\tglobal_load_lds_dwordx4 %1, %2\n\ts_mov_b32 m0, %0" : "=&s"(keep) : "v"(voff), "s"(sbase), "s"(lds_dst) : "memory"); }
template <bool L> __device__ __forceinline__ unsigned pg8_lv(unsigned v) { if constexpr (L) asm volatile("" : "+v"(v)); return v; }
template <class Epi, class Sched, bool ALIGN_EPI = false, bool SP2 = false, bool FP8 = false>
__device__ __forceinline__ void gemm_phase(PG8_LAS unsigned char* lds, const Gemm g, const Sched& S, const Epi& E, const int wave_s) {
    int tid_ = wave_s * 64 + mk_lane(); asm volatile("" : "+v"(tid_));
    int wid_ = wave_s; asm volatile("" : "+s"(wid_));
    const int tid = tid_, wid = wid_, lane = tid & 63, wr = wid >> 2, wc = wid & 3, fr = lane & 15, fq = lane >> 4;
    const int KB = FP8 ? g.K : 2 * g.K, nt = KB / (2 * BK);
    unsigned voffA[2], voffB[2];
#pragma unroll
    for (int i = 0; i < 2; ++i) { int R, C; stage_rc(tid * 16 + i * 8192, R, C); const int Rb = Epi::PERM ? ((R & ~31) + perm32(R & 31)) : R;
        voffA[i] = (unsigned)(R * KB + C * 2); voffB[i] = (unsigned)(Rb * KB + C * 2); }
    const size_t kstep = (size_t)(BK * 2);
    const size_t hstep = (size_t)HALF * KB;
    const size_t tstep = 2 * hstep;
    const unsigned ldsw = (unsigned)wid * 1024u;
    const int aoff = lds_byte(wr * 64 + fr, fq * 8), boff = lds_byte(wc * 32 + fr, fq * 8);
#define PG8_SA(b, h) (((b) * 2 + (h)) * HTB)
#define PG8_SB(b, h) ((4 + (b) * 2 + (h)) * HTB)
#define PG8_STAGE(bufoff, gbase, voff) do { _Pragma("unroll") for (int _i = 0; _i < 2; ++_i) \
        __builtin_amdgcn_global_load_lds((const unsigned*)((const char*)(gbase) + pg8_lv<(FP8 || Epi::LV)>((voff)[_i])), (PG8_LAS unsigned*)(lds + (bufoff) + ldsw + _i * 8192), 16, 0, 0); } while (0)
#define PG8_LDA(dst, b, h) do { _Pragma("unroll") for (int m = 0; m < 4; ++m) _Pragma("unroll") for (int k = 0; k < 2; ++k) dst[m][k] = *(const PG8_LAS bf16x8*)(lds + PG8_SA(b, h) + aoff + m * 2048 + k * 1024); } while (0)
#define PG8_LDB(dst, b, h) do { _Pragma("unroll") for (int n = 0; n < 2; ++n) _Pragma("unroll") for (int k = 0; k < 2; ++k) dst[n][k] = *(const PG8_LAS bf16x8*)(lds + PG8_SB(b, h) + boff + n * 2048 + k * 1024); } while (0)
#define PG8_CAT(x0, x1) __builtin_bit_cast(v8i32, __builtin_shufflevector((x0), (x1), 0, 1, 2, 3, 4, 5, 6, 7, 8, 9, 10, 11, 12, 13, 14, 15))
#define PG8_MMA(ai, bj, At, Bt) do { __builtin_amdgcn_s_setprio(1); _Pragma("unroll") for (int m = 0; m < 4; ++m) _Pragma("unroll") for (int n = 0; n < 2; ++n) { \
        if constexpr (FP8) acc[ai][bj][m][n] = __builtin_amdgcn_mfma_scale_f32_16x16x128_f8f6f4(PG8_CAT(Bt[n][0], Bt[n][1]), PG8_CAT(At[m][0], At[m][1]), acc[ai][bj][m][n], 0, 0, 0, 0, 0, 0); \
        else { _Pragma("unroll") for (int k = 0; k < 2; ++k) acc[ai][bj][m][n] = __builtin_amdgcn_mfma_f32_16x16x32_bf16(Bt[n][k], At[m][k], acc[ai][bj][m][n], 0, 0, 0); } } __builtin_amdgcn_s_setprio(0); } while (0)
#if defined(PG8_SAFE_WAITS) && PG8_SAFE_WAITS
#define PG8_WAIT_V(n) asm volatile("s_waitcnt vmcnt(0)" ::: "memory")
#else
#define PG8_WAIT_V(n) asm volatile("s_waitcnt vmcnt(" #n ")" ::: "memory")
#endif
#define PG8_WAIT_L(n) asm volatile("s_waitcnt lgkmcnt(" #n ")" ::: "memory")
#if defined(PG8_SAFE_WAITS) && PG8_SAFE_WAITS
#define PG8_WAIT_VR(r) asm volatile("s_waitcnt vmcnt(0)" ::: "memory")
#else
#define PG8_WAIT_VR(r) do { if (r) { if constexpr (Epi::NST >= 16) asm volatile("s_waitcnt vmcnt(24)" ::: "memory"); else { static_assert(Epi::NST >= 8, "relaxed waits: at least 8 epilogue stores"); asm volatile("s_waitcnt vmcnt(16)" ::: "memory"); } } else asm volatile("s_waitcnt vmcnt(8)" ::: "memory"); } while (0)
#endif
#define PG8_BAR __builtin_amdgcn_s_barrier()
#define PG8_SCHED __builtin_amdgcn_sched_barrier(0)
    Unit cur, nxt; int ui = 0;
    if (!S.next(0, cur)) return;
    f32x4 acc[2][2][4][2];
#pragma unroll
    for (int a = 0; a < 2; ++a)
#pragma unroll
        for (int b = 0; b < 2; ++b)
#pragma unroll
            for (int m = 0; m < 4; ++m)
#pragma unroll
                for (int n = 0; n < 2; ++n) acc[a][b][m][n] = (f32x4){0.f, 0.f, 0.f, 0.f};
    bf16x8 At[4][2], B0[2][2], B1[2][2];
    const char* cA = (const char*)g.A + (size_t)cur.pm * tstep; const char* cB = (const char*)g.Bt + (size_t)cur.pn * tstep;
    S.a_ready(cur);
    if constexpr (SP2) {
        PG8_STAGE(PG8_SB(0, 0), cB, voffB); PG8_STAGE(PG8_SB(0, 1), cB + hstep, voffB); PG8_STAGE(PG8_SA(0, 0), cA, voffA); PG8_STAGE(PG8_SA(0, 1), cA + hstep, voffA);
        if (wr == 1) PG8_BAR;
        PG8_WAIT_V(2); PG8_BAR;
        PG8_STAGE(PG8_SB(1, 0), cB + kstep, voffB); PG8_STAGE(PG8_SA(1, 0), cA + kstep, voffA); PG8_STAGE(PG8_SB(1, 1), cB + hstep + kstep, voffB);
        PG8_WAIT_V(6); PG8_BAR;
    } else {
        PG8_STAGE(PG8_SB(0, 0), cB, voffB); PG8_STAGE(PG8_SA(0, 0), cA, voffA); PG8_STAGE(PG8_SB(0, 1), cB + hstep, voffB); PG8_STAGE(PG8_SA(0, 1), cA + hstep, voffA);
        if (wr == 1) PG8_BAR;
        PG8_WAIT_V(4); PG8_BAR;
        PG8_STAGE(PG8_SB(1, 0), cB + kstep, voffB); PG8_STAGE(PG8_SA(1, 0), cA + kstep, voffA); PG8_STAGE(PG8_SB(1, 1), cB + hstep + kstep, voffB);
        PG8_WAIT_V(6); PG8_BAR;
    }
    for (;;) {
        const int lt_ = mk_lane(), fr = lt_ & 15, fq = lt_ >> 4;
        unsigned voffA[2], voffB[2];
#pragma unroll
        for (int i = 0; i < 2; ++i) { int R, C; stage_rc((wid * 64 + lt_) * 16 + i * 8192, R, C); const int Rb = Epi::PERM ? ((R & ~31) + perm32(R & 31)) : R;
            voffA[i] = (unsigned)(R * KB + C * 2); voffB[i] = (unsigned)(Rb * KB + C * 2); }
        const int aoff = lds_byte(wr * 64 + fr, fq * 8), boff = lds_byte(wc * 32 + fr, fq * 8);
        const bool has_next = S.next(ui + 1, nxt);
        const char* nA = has_next ? (const char*)g.A + (size_t)nxt.pm * tstep : cA; const char* nB = has_next ? (const char*)g.Bt + (size_t)nxt.pn * tstep : cB;
#define PG8_PAIR_SP2(RLX, t) PG8_PAIR_SP2X(RLX, t, cA, cB, nA, nB)
          \
#define PG8_PAIR_SP2X(RLX, t, BA, BB, NXA, NXB) do { \
            const bool last = ((t) == nt - 2); \
            const char* a1 = (BA) + (size_t)((t) + 1) * kstep; \
            const char* a2 = last ? (NXA) : (BA) + (size_t)((t) + 2) * kstep; const char* b2 = last ? (NXB) : (BB) + (size_t)((t) + 2) * kstep; \
            const char* a3 = a2 + kstep; const char* b3 = b2 + kstep; \
            if (last && has_next) S.a_ready(nxt); \
            PG8_LDB(B0, 0, 0); PG8_LDB(B1, 0, 1); PG8_SCHED; PG8_LDA(At, 0, 0); if (!(RLX)) PG8_STAGE(PG8_SA(1, 1), a1 + hstep, voffA); \
            PG8_WAIT_VR(RLX); PG8_WAIT_L(0); PG8_BAR; PG8_MMA(0, 0, At, B0); PG8_MMA(0, 1, At, B1); PG8_BAR; PG8_SCHED; \
            PG8_LDA(At, 0, 1); PG8_STAGE(PG8_SB(0, 0), b2, voffB); PG8_STAGE(PG8_SB(0, 1), b2 + hstep, voffB); PG8_STAGE(PG8_SA(0, 0), a2, voffA); \
            PG8_WAIT_VR(RLX); PG8_WAIT_L(0); PG8_BAR; PG8_MMA(1, 0, At, B0); PG8_MMA(1, 1, At, B1); PG8_BAR; PG8_SCHED; \
            PG8_LDB(B0, 1, 0); PG8_LDB(B1, 1, 1); PG8_SCHED; PG8_LDA(At, 1, 0); PG8_STAGE(PG8_SA(0, 1), a2 + hstep, voffA); \
            PG8_WAIT_VR(RLX); PG8_WAIT_L(0); PG8_BAR; PG8_MMA(0, 0, At, B0); PG8_MMA(0, 1, At, B1); PG8_BAR; PG8_SCHED; \
            PG8_LDA(At, 1, 1); PG8_STAGE(PG8_SB(1, 0), b3, voffB); PG8_STAGE(PG8_SB(1, 1), b3 + hstep, voffB); PG8_STAGE(PG8_SA(1, 0), a3, voffA); \
            PG8_WAIT_V(8); PG8_WAIT_L(0); PG8_BAR; PG8_MMA(1, 0, At, B0); PG8_MMA(1, 1, At, B1); PG8_BAR; PG8_SCHED; } while (0)
        if constexpr (SP2) {
#if PG8_RELAX == 2
            for (int t = 0; t < nt; t += 2) { const bool rlx = (t == 0) && (ui > 0); PG8_PAIR_SP2(rlx, t); }
#else
            int t0 = 0;
            if constexpr (Sched::DUAL) {
                const char* cA2 = S.opA2() + (size_t)cur.pm * tstep; const char* cB2 = S.opB2() + (size_t)cur.pn * tstep;
                if constexpr (PG8_RELAX) { if (ui > 0) { PG8_PAIR_SP2X(1, 0, cA, cB, cA2, cB2); t0 = 2; } }
                for (int t = t0; t < nt; t += 2) PG8_PAIR_SP2X(0, t, cA, cB, cA2, cB2);
                {   Unit um = cur; asm volatile("" : "+s"(um.pm), "+s"(um.pn)); const int lm_ = mk_lane(); E.mid(acc, um, wr, wc, lm_ & 15, lm_ >> 4); }
                for (int t = 0; t < nt; t += 2) PG8_PAIR_SP2X(0, t, cA2, cB2, nA, nB);
            } else {
            if constexpr (PG8_RELAX) { if (ui > 0) { PG8_PAIR_SP2(1, 0); t0 = 2; } }
            for (int t = t0; t < nt; t += 2) PG8_PAIR_SP2(0, t);
            }
#endif
        } else {
        for (int t = 0; t < nt; t += 2) {
            const bool last = (t == nt - 2);
            const char* a1 = cA + (size_t)(t + 1) * kstep;
            const char* a2 = last ? nA : cA + (size_t)(t + 2) * kstep; const char* b2 = last ? nB : cB + (size_t)(t + 2) * kstep;
            const char* a3 = a2 + kstep; const char* b3 = b2 + kstep;
            if (last && has_next) S.a_ready(nxt);
            PG8_LDB(B0, 0, 0); PG8_SCHED; PG8_LDA(At, 0, 0); PG8_STAGE(PG8_SA(1, 1), a1 + hstep, voffA);
            PG8_WAIT_L(8); PG8_BAR; PG8_WAIT_L(0); PG8_MMA(0, 0, At, B0); PG8_BAR; PG8_SCHED;
            PG8_LDB(B1, 0, 1); PG8_STAGE(PG8_SB(0, 0), b2, voffB);
            PG8_BAR; PG8_WAIT_L(0); PG8_MMA(0, 1, At, B1); PG8_BAR;
            PG8_LDA(At, 0, 1); PG8_STAGE(PG8_SA(0, 0), a2, voffA);
            PG8_BAR; PG8_WAIT_L(0); PG8_MMA(1, 0, At, B0); PG8_BAR; PG8_SCHED;
            PG8_STAGE(PG8_SB(0, 1), b2 + hstep, voffB);
            PG8_WAIT_V(6); PG8_BAR; PG8_MMA(1, 1, At, B1); PG8_BAR;
            PG8_LDB(B0, 1, 0); PG8_SCHED; PG8_LDA(At, 1, 0); PG8_STAGE(PG8_SA(0, 1), a2 + hstep, voffA);
            PG8_WAIT_L(8); PG8_BAR; PG8_WAIT_L(0); PG8_MMA(0, 0, At, B0); PG8_BAR; PG8_SCHED;
            PG8_LDB(B1, 1, 1); PG8_STAGE(PG8_SB(1, 0), b3, voffB);
            PG8_BAR; PG8_WAIT_L(0); PG8_MMA(0, 1, At, B1); PG8_BAR;
            PG8_LDA(At, 1, 1); PG8_STAGE(PG8_SA(1, 0), a3, voffA);
            PG8_BAR; PG8_WAIT_L(0); PG8_MMA(1, 0, At, B0); PG8_BAR; PG8_SCHED;
            PG8_STAGE(PG8_SB(1, 1), b3 + hstep, voffB);
            PG8_WAIT_V(6); PG8_BAR; PG8_MMA(1, 1, At, B1); PG8_BAR;
        }
        }
#undef PG8_PAIR_SP2
#undef PG8_PAIR_SP2X
        if constexpr (ALIGN_EPI) { if (wr == 0) PG8_BAR; }
        if constexpr (SP2 && PG8_RELAX) { if (has_next) {
            const char* eb = nA + kstep + hstep;
#pragma unroll
            for (int i_ = 0; i_ < 2; ++i_) { unsigned vo_ = voffA[i_]; asm volatile("" : "+v"(vo_));
                glds16_asm(eb, vo_, (unsigned)__builtin_amdgcn_readfirstlane((int)(unsigned)(size_t)(lds + PG8_SA(1, 1)) + (int)ldsw + i_ * 8192)); }
            PG8_SCHED; } }
        if constexpr (!Epi::AFTER_DRAIN) { Unit ue = cur; asm volatile("" : "+s"(ue.pm), "+s"(ue.pn));
            const int le_ = mk_lane(); E(acc, ue, wr, wc, le_ & 15, le_ >> 4); S.done(cur); }
        if (!has_next) break;
#pragma unroll
        for (int a = 0; a < 2; ++a)
#pragma unroll
            for (int b = 0; b < 2; ++b)
#pragma unroll
                for (int m = 0; m < 4; ++m)
#pragma unroll
                    for (int n = 0; n < 2; ++n) acc[a][b][m][n] = (f32x4){0.f, 0.f, 0.f, 0.f};
        cur = nxt; cA = nA; cB = nB; ++ui;
        if constexpr (ALIGN_EPI) { if (wr == 1) PG8_BAR; }
    }
    PG8_WAIT_V(0);
    if constexpr (!ALIGN_EPI) { if (wr == 0) PG8_BAR; }
    PG8_BAR;
    if constexpr (Epi::AFTER_DRAIN) { E.fused(acc, cur, wr, wc, fr, fq, lds, wid, lane); S.done(cur); }
#undef PG8_SA
#undef PG8_SB
#undef PG8_STAGE
#undef PG8_LDA
#undef PG8_LDB
#undef PG8_MMA
#undef PG8_CAT
#undef PG8_WAIT_V
#undef PG8_WAIT_L
#undef PG8_WAIT_VR
#undef PG8_BAR
#undef PG8_SCHED
}
}

namespace att {
typedef unsigned short bf16_t;
using bf16x8 = __attribute__((ext_vector_type(8))) short;
using s16x4  = __attribute__((ext_vector_type(4))) short;
using f32x16 = __attribute__((ext_vector_type(16))) float;
using f32x4  = __attribute__((ext_vector_type(4))) float;
using u32x4  = __attribute__((ext_vector_type(4))) unsigned;
#define ATT_LAS __attribute__((address_space(3)))
constexpr int   D = 128, NW = 8, QBLK = 32, KVBLK = 64;
constexpr float SCALE = 0.088388347648318440f;
constexpr float THR = 8.f;
constexpr int SHM_V = KVBLK * D * 2, SHM_K = KVBLK * D * 2, SHM_ATTN = 2 * SHM_V + 2 * SHM_K + NW * 64 * 4;
#define KSWZ(row, colB) ((row) * 256 + ((colB) ^ (((row) & 7) << 4)))
#define SBAR() __builtin_amdgcn_sched_barrier(0)
__device__ __forceinline__ int crow(int r, int hi) { return (r & 3) + 8 * (r >> 2) + 4 * hi; }
typedef float f32x2_t __attribute__((ext_vector_type(2)));
typedef __bf16 bf16x2_t __attribute__((ext_vector_type(2)));
__device__ __forceinline__ unsigned cvtpk(float lo, float hi) { const f32x2_t v = {lo, hi}; const bf16x2_t b = __builtin_convertvector(v, bf16x2_t); return __builtin_bit_cast(unsigned, b); }

template <bool FIXED> __device__ __forceinline__ void partialSM(f32x16& p0, f32x16& p1, float& m_reg, float& mn, float& alpha, const float mCfix) {
  constexpr float C = SCALE * 1.4426950408889634f;
  if constexpr (FIXED) { alpha = 1.f; mn = 0.f; (void)mCfix;
#pragma unroll
    for (int r = 0; r < 16; ++r) p0[r] = __builtin_amdgcn_exp2f(p0[r]);
    return; }
  float pmax = p0[0];
#pragma unroll
  for (int r = 1; r < 16; ++r) pmax = fmaxf(pmax, p0[r]);
#pragma unroll
  for (int r = 0; r < 16; ++r) pmax = fmaxf(pmax, p1[r]);
  { auto rr = __builtin_amdgcn_permlane32_swap(__float_as_uint(pmax), __float_as_uint(pmax), false, false);
    pmax = fmaxf(__uint_as_float(rr[0]), __uint_as_float(rr[1])); }
  if (__builtin_expect(__all(pmax - m_reg <= THR / SCALE), 1)) { mn = m_reg; alpha = 1.f; }
  else { mn = fmaxf(m_reg, pmax); alpha = __builtin_amdgcn_exp2f((m_reg - mn) * C); m_reg = mn; }
  float mnC = -mn * C;
#pragma unroll
  for (int r = 0; r < 16; ++r) p0[r] = fmaf(p0[r], C, mnC);
#pragma unroll
  for (int r = 0; r < 16; ++r) p1[r] = fmaf(p1[r], C, mnC);
#pragma unroll
  for (int r = 0; r < 16; ++r) p0[r] = __builtin_amdgcn_exp2f(p0[r]);
}
__device__ __forceinline__ void finishSM(f32x16& p0, f32x16& p1, float alpha, float& l_reg, bf16x8& pa0, bf16x8& pa1, bf16x8& pa2, bf16x8& pa3) {
#pragma unroll
  for (int r = 0; r < 16; ++r) p1[r] = __builtin_amdgcn_exp2f(p1[r]);
  float ps = 0;
#pragma unroll
  for (int r = 0; r < 16; ++r) ps += p0[r];
#pragma unroll
  for (int r = 0; r < 16; ++r) ps += p1[r];
  { auto rr = __builtin_amdgcn_permlane32_swap(__float_as_uint(ps), __float_as_uint(ps), false, false);
    ps = __uint_as_float(rr[0]) + __uint_as_float(rr[1]); }
  l_reg = l_reg * alpha + ps;
#define PK4(P, BASE, OUT) do { unsigned a0 = cvtpk(P[BASE + 0], P[BASE + 1]), a1 = cvtpk(P[BASE + 2], P[BASE + 3]);   \
    unsigned b0 = cvtpk(P[BASE + 4], P[BASE + 5]), b1 = cvtpk(P[BASE + 6], P[BASE + 7]);                              \
    auto r0 = __builtin_amdgcn_permlane32_swap(a0, b0, false, false); auto r1 = __builtin_amdgcn_permlane32_swap(a1, b1, false, false); \
    u32x4 w = {r0[0], r1[0], r0[1], r1[1]}; OUT = __builtin_bit_cast(bf16x8, w); } while (0)
  PK4(p0, 0, pa0); PK4(p0, 8, pa1); PK4(p1, 0, pa2); PK4(p1, 8, pa3);
#undef PK4
}
template <bool FIXED> __device__ __forceinline__ void qkt(f32x16& p0, f32x16& p1, const ATT_LAS char* Ks, const bf16x8* qr, int r32, int hi, const f32x16& cinit) {
  if constexpr (!FIXED) { p0 = f32x16{}; p1 = f32x16{}; }
#pragma unroll
  for (int d0 = 0; d0 < 8; ++d0) { int cb = (d0 * 16 + hi * 8) * 2;
    bf16x8 b0 = *(const ATT_LAS bf16x8*)(Ks + KSWZ(r32, cb));
    bf16x8 b1 = *(const ATT_LAS bf16x8*)(Ks + KSWZ(32 + r32, cb));
    if (FIXED && d0 == 0) { p0 = __builtin_amdgcn_mfma_f32_32x32x16_bf16(b0, qr[d0], cinit, 0, 0, 0); p1 = __builtin_amdgcn_mfma_f32_32x32x16_bf16(b1, qr[d0], cinit, 0, 0, 0); }
    else { p0 = __builtin_amdgcn_mfma_f32_32x32x16_bf16(b0, qr[d0], p0, 0, 0, 0); p1 = __builtin_amdgcn_mfma_f32_32x32x16_bf16(b1, qr[d0], p1, 0, 0, 0); } }
}
__device__ __forceinline__ int v_st(int k, int c) { const int kk = (k & ~0xC) | ((k & 4) << 1) | ((k & 8) >> 1); return ((kk >> 3) * 4 + (c >> 5)) * 512 + ((kk & 7) * 32 + (c & 31)) * 2; }
__device__ __forceinline__ int v_rd_base(int lane) { return ((lane & 3) << 3) | (((lane >> 2) & 3) << 6) | (((lane >> 4) & 1) << 5) | (((lane >> 5) & 1) << 8); }
constexpr int v_rd_off(int d0, int ks, int half) { return d0 * 512 + ks * 4096 + half * 2048; }
template <int OFF> __device__ __forceinline__ s16x4 tr_read(int vb) {
  s16x4 r; asm volatile("ds_read_b64_tr_b16 %0, %1 offset:%2" : "=&v"(r) : "v"(vb), "i"(OFF) : "memory"); return r;
}
template <int D0> __device__ __forceinline__ void pv_one(f32x16& od, int vb, bf16x8 pa0, bf16x8 pa1, bf16x8 pa2, bf16x8 pa3) {
  const s16x4 l0 = tr_read<v_rd_off(D0, 0, 0)>(vb), h0 = tr_read<v_rd_off(D0, 0, 1)>(vb), l1 = tr_read<v_rd_off(D0, 1, 0)>(vb), h1 = tr_read<v_rd_off(D0, 1, 1)>(vb);
  const s16x4 l2 = tr_read<v_rd_off(D0, 2, 0)>(vb), h2 = tr_read<v_rd_off(D0, 2, 1)>(vb), l3 = tr_read<v_rd_off(D0, 3, 0)>(vb), h3 = tr_read<v_rd_off(D0, 3, 1)>(vb);
  asm volatile("s_waitcnt lgkmcnt(0)" ::: "memory"); SBAR();
#define PK(L, H) (bf16x8){L[0], L[1], L[2], L[3], H[0], H[1], H[2], H[3]}
  od = __builtin_amdgcn_mfma_f32_32x32x16_bf16(pa0, PK(l0, h0), od, 0, 0, 0);
  od = __builtin_amdgcn_mfma_f32_32x32x16_bf16(pa1, PK(l1, h1), od, 0, 0, 0);
  od = __builtin_amdgcn_mfma_f32_32x32x16_bf16(pa2, PK(l2, h2), od, 0, 0, 0);
  od = __builtin_amdgcn_mfma_f32_32x32x16_bf16(pa3, PK(l3, h3), od, 0, 0, 0);
#undef PK
}
__device__ __forceinline__ void pv_d0(f32x16* o, int vb, bf16x8 pa0, bf16x8 pa1, bf16x8 pa2, bf16x8 pa3) {
  pv_one<0>(o[0], vb, pa0, pa1, pa2, pa3); pv_one<1>(o[1], vb, pa0, pa1, pa2, pa3); pv_one<2>(o[2], vb, pa0, pa1, pa2, pa3); pv_one<3>(o[3], vb, pa0, pa1, pa2, pa3);
}
__device__ __forceinline__ float bflo(unsigned w) { return __uint_as_float(w << 16); }
__device__ __forceinline__ float bfhi(unsigned w) { return __uint_as_float(w & 0xffff0000u); }

template <int LDQ, int LDK, int LDO, bool FIXED>
__device__ __forceinline__ void attn_unit(const bf16_t* __restrict__ Qb, const bf16_t* __restrict__ Kh, const bf16_t* __restrict__ Vh, bf16_t* __restrict__ Ob,
                                          int t0, const float* __restrict__ qg, const float* __restrict__ rope, int seq, ATT_LAS char* lds, const int wave_s, const float mCfix) {
  int tid_ = wave_s * 64 + mk_lane(); asm volatile("" : "+v"(tid_));
  int wid_ = wave_s; asm volatile("" : "+s"(wid_));
  const int tid = tid_, wid = wid_, lane = tid & 63, r32 = lane & 31, hi = lane >> 5;
  ATT_LAS char* V_lds = lds; ATT_LAS char* K_lds = lds + 2 * SHM_V;
  ATT_LAS float* ws = (ATT_LAS float*)(lds + 2 * SHM_V + 2 * SHM_K) + wid * 64; ATT_LAS float* li_l = ws; ATT_LAS float* al_l = ws + 32;
  float m_reg = -1e30f, l_reg = 0; f32x16 o[4] = {}; bf16x8 qr[8];
  f32x16 cinit;
#pragma unroll
  for (int r = 0; r < 16; ++r) cinit[r] = FIXED ? mCfix : 0.f;
  {
    const bf16_t* Qw = Qb + (size_t)(wid * QBLK + r32) * LDQ + hi * 8;
#pragma unroll
    for (int d0 = 0; d0 < 8; ++d0) qr[d0] = *(const bf16x8*)(Qw + d0 * 16);
    (void)qg; (void)rope; (void)t0;
  }
  const int sr = tid >> 4, sc = (tid & 15) * 8, vst0 = v_st(sr, sc), vst1 = v_st(32 + sr, sc);
  const int vb0 = (int)(unsigned)(size_t)V_lds + v_rd_base(lane);
  struct { bf16x8 vs0, vs1, ks0, ks1; } sr_[2];
#define SLOAD(i, k0) do { sr_[i].vs0 = *(const bf16x8*)(Vh + (size_t)((k0) + sr) * LDK + sc); sr_[i].vs1 = *(const bf16x8*)(Vh + (size_t)((k0) + 32 + sr) * LDK + sc); \
    sr_[i].ks0 = *(const bf16x8*)(Kh + (size_t)((k0) + sr) * LDK + sc); sr_[i].ks1 = *(const bf16x8*)(Kh + (size_t)((k0) + 32 + sr) * LDK + sc); } while (0)
#define SWRITE(b, i) do { *(ATT_LAS bf16x8*)(V_lds + (b) * SHM_V + vst0) = sr_[i].vs0;          \
    *(ATT_LAS bf16x8*)(V_lds + (b) * SHM_V + vst1) = sr_[i].vs1; const int kc = sc * 2;               \
    *(ATT_LAS bf16x8*)(K_lds + (b) * SHM_K + KSWZ(sr, kc)) = sr_[i].ks0;                       \
    *(ATT_LAS bf16x8*)(K_lds + (b) * SHM_K + KSWZ(32 + sr, kc)) = sr_[i].ks1; } while (0)
#define SWAIT() asm volatile("s_waitcnt vmcnt(4)" ::: "memory")
#define RESC(a) do { if constexpr (!FIXED) if (__any((a) < 1.f)) { if (hi == 0) al_l[r32] = (a); asm volatile("s_waitcnt lgkmcnt(0)" ::: "memory"); \
    _Pragma("unroll") for (int d = 0; d < 4; ++d) _Pragma("unroll") for (int r = 0; r < 16; ++r) o[d][r] *= al_l[crow(r, hi)]; } } while (0)
  f32x16 pA0, pA1, pB0, pB1; float mnA, mnB, alA, alB; bf16x8 pa0, pa1, pa2, pa3; const int NT = seq / KVBLK;
  constexpr int SE = 0, SO = 1;
  SLOAD(SE, 0); asm volatile("s_waitcnt vmcnt(0)" ::: "memory"); SWRITE(0, SE); __syncthreads();
  qkt<FIXED>(pA0, pA1, K_lds, qr, r32, hi, cinit); partialSM<FIXED>(pA0, pA1, m_reg, mnA, alA, mCfix);
  SLOAD(SO, KVBLK); if (2 < NT) SLOAD(SE, 2 * KVBLK);
  SWAIT(); SWRITE(1, SO); __syncthreads();
  for (int j = 1; j + 1 < NT; j += 2) {
    SBAR(); qkt<FIXED>(pB0, pB1, K_lds + SHM_K, qr, r32, hi, cinit);
    finishSM(pA0, pA1, alA, l_reg, pa0, pa1, pa2, pa3); SBAR();
    SLOAD(SO, (j + 2) * KVBLK); SBAR();
    pv_d0(o, vb0, pa0, pa1, pa2, pa3); partialSM<FIXED>(pB0, pB1, m_reg, mnB, alB, mCfix);
    __syncthreads(); SWAIT(); SWRITE(0, SE);
    RESC(alB); __syncthreads();
    SBAR(); qkt<FIXED>(pA0, pA1, K_lds, qr, r32, hi, cinit);
    finishSM(pB0, pB1, alB, l_reg, pa0, pa1, pa2, pa3); SBAR();
    if (j + 3 < NT) SLOAD(SE, (j + 3) * KVBLK); SBAR();
    pv_d0(o, vb0 + SHM_V, pa0, pa1, pa2, pa3); partialSM<FIXED>(pA0, pA1, m_reg, mnA, alA, mCfix);
    __syncthreads(); SWAIT(); SWRITE(1, SO);
    RESC(alA); __syncthreads();
  }
  SBAR(); qkt<FIXED>(pB0, pB1, K_lds + SHM_K, qr, r32, hi, cinit);
  finishSM(pA0, pA1, alA, l_reg, pa0, pa1, pa2, pa3); SBAR();
  pv_d0(o, vb0, pa0, pa1, pa2, pa3); partialSM<FIXED>(pB0, pB1, m_reg, mnB, alB, mCfix);
  __syncthreads(); RESC(alB);
  finishSM(pB0, pB1, alB, l_reg, pa0, pa1, pa2, pa3); SBAR();
  pv_d0(o, vb0 + SHM_V, pa0, pa1, pa2, pa3);
  if (hi == 0) li_l[r32] = l_reg; asm volatile("s_waitcnt lgkmcnt(0)" ::: "memory");
  float rli[16];
#pragma unroll
  for (int r = 0; r < 16; ++r) rli[r] = __builtin_amdgcn_rcpf(li_l[crow(r, hi)]);
  bf16_t* Ow = Ob + (size_t)(wid * QBLK) * LDO;
#pragma unroll
  for (int r = 0; r < 16; ++r) { const int orow = crow(r, hi);
#pragma unroll
    for (int d0 = 0; d0 < 4; ++d0) { const float v = o[d0][r] * rli[r]; Ow[(size_t)orow * LDO + d0 * 32 + r32] = (bf16_t)(cvtpk(v, v) & 0xffffu); } }
#undef SLOAD
#undef SWRITE
#undef SWAIT
#undef RESC
}
}

#ifndef WGM_BIG
#define WGM_BIG 8
#endif
#ifndef WGM_SQ
#define WGM_SQ 4
#endif
#ifndef MK_PER_PHASE
#define MK_PER_PHASE 0
#endif
#ifndef PG8_SP2
#define PG8_SP2 true
#endif
#ifndef PG8_ALIGN
#define PG8_ALIGN true
#endif
constexpr int NWAVES = 8;
constexpr int BATCH = 4, SEQ = 4096, DM = 2048, DEPTH = 4, HD = 128, NQH = 16, NKVH = 4, DFF = 8192, INW = 13312;
constexpr int M = BATCH * SEQ;
constexpr int ZW = 11264;
constexpr int Z_CB = 0, Z_U = 2048, Z_Q = 4096, Z_K = 6144, Z_V = 6656, Z_GA = 7168, Z_GB = 9216;
constexpr int G_GATE0 = 9216;
constexpr float RMS_EPS = 1e-6f;
constexpr size_t MiB = 1u << 20;
constexpr size_t WS_CTL = 0, CTL_ZERO_BYTES = 1 * MiB;
constexpr size_t WS_ROPE = 1 * MiB;
constexpr size_t WS_RS = WS_ROPE + 256 * 1024;
constexpr size_t WS_W = 2 * MiB, W_LAYER = 140 * MiB;
constexpr size_t W_IN = 0, W_OC = 52 * MiB, W_OA = 60 * MiB, W_MG = 68 * MiB, W_UP = 76 * MiB, W_DN = 108 * MiB;
constexpr size_t WS_H = WS_W + DEPTH * W_LAYER;
constexpr size_t W_G8 = 36 * MiB;
constexpr int N_MAIN = 9216, N_GATE = 4096;
constexpr float G8_SCALE = 64.f;
constexpr size_t WS_Z = WS_H + 64 * MiB;
constexpr size_t WS_CA = WS_Z + 416 * MiB;
constexpr size_t WS_O = WS_CA + 64 * MiB;
constexpr size_t WS_P = WS_O + 64 * MiB;
constexpr size_t WS_G = WS_P + 64 * MiB;
constexpr size_t WS_F = WS_G + 64 * MiB;
constexpr size_t WS_X = WS_F + 64 * MiB;
constexpr size_t WS_END = WS_F + 128 * MiB;
static_assert((size_t)INW * DM * 2 <= 52 * MiB && (size_t)M * ZW * 2 <= 416 * MiB && (size_t)M * DFF * 2 <= 416 * MiB, "d_ws map");
constexpr int CW_BAR = 4096;
constexpr int RING_BYTES = 131072, LDSCTL_OFF = RING_BYTES, MISC_OFF = LDSCTL_OFF + 320, LDS_BYTES = 147456;

#define GAS __attribute__((address_space(1)))
#define LAS __attribute__((address_space(3)))
typedef unsigned short bf16;
typedef unsigned v4u __attribute__((ext_vector_type(4)));
typedef unsigned v2u __attribute__((ext_vector_type(2)));
typedef float f32x4 __attribute__((ext_vector_type(4)));
typedef GAS unsigned gu32;
#define LDS_WAIT() asm volatile("s_waitcnt lgkmcnt(0)" ::: "memory")
__device__ __forceinline__ unsigned f2bf(float f) { unsigned u = __builtin_bit_cast(unsigned, f); return (u + 0x7fffu + ((u >> 16) & 1u)) >> 16; }
typedef float f32x2_t __attribute__((ext_vector_type(2)));
typedef __bf16 bf16x2_t __attribute__((ext_vector_type(2)));
__device__ __forceinline__ unsigned pk2(float lo, float hi) { const f32x2_t v = {lo, hi}; const bf16x2_t b = __builtin_convertvector(v, bf16x2_t); return __builtin_bit_cast(unsigned, b); }
__device__ __forceinline__ unsigned pk_fp8x4(float a, float b, float c, float d) { int w = __builtin_amdgcn_cvt_pk_fp8_f32(a, b, 0, false); w = __builtin_amdgcn_cvt_pk_fp8_f32(c, d, w, true); return (unsigned)w; }
__device__ __forceinline__ float bflo(unsigned w) { return __uint_as_float(w << 16); }
__device__ __forceinline__ float bfhi(unsigned w) { return __uint_as_float(w & 0xffff0000u); }

#define XB_TMO      128
#define XB_XCNT(j)  (256  + 64 * (j))
#define XB_XSUB(j)  (1280 + 64 * (j))
#define XB_XGEN(j)  (2304 + 64 * (j))
#define XB_TOP      3328
#define XB_TOPGEN   3392
#define XCD_BAR_WORDS 3456
#define XB_SPIN_CAP (1u << 18)

__device__ __forceinline__ unsigned xb_ld(unsigned* p)              { return __hip_atomic_load(p, __ATOMIC_RELAXED, __HIP_MEMORY_SCOPE_AGENT); }
__device__ __forceinline__ unsigned xb_add(unsigned* p, unsigned v) { return __hip_atomic_fetch_add(p, v, __ATOMIC_RELAXED, __HIP_MEMORY_SCOPE_AGENT); }
__device__ __forceinline__ unsigned xb_xcc_id() { return (unsigned)__builtin_amdgcn_s_getreg((3 << 11) | 20) & 0xFu; }
#define XB_SPIN(cond, bar) do { unsigned _sp = 0; while (cond) { __builtin_amdgcn_s_sleep(1); \
    if ((++_sp & 255u) == 0u) { if (xb_ld(&(bar)[XB_TMO])) break; if (_sp > XB_SPIN_CAP) { atomicAdd(&(bar)[XB_TMO], 1u); break; } } } } while (0)

struct XcdBarrier {
    unsigned* bar; unsigned x;
    volatile LAS unsigned* st;
};

__device__ __forceinline__ XcdBarrier xcd_barrier_post(unsigned* bar, volatile LAS unsigned* st, const bool t0  ) {
    XcdBarrier b; b.bar = bar; b.x = xb_xcc_id(); b.st = st;
    if (t0) (void)xb_add(&bar[XB_XCNT(b.x)], 1u);
    return b;
}
__device__ __forceinline__ void xcd_barrier_complete(unsigned* bar, unsigned x, unsigned& nloc, unsigned& nx) {
    const unsigned G = gridDim.x * gridDim.y * gridDim.z;
    unsigned sum, cnt, mine, sp = 0u;
    for (;;) {
        sum = 0u; cnt = 0u; mine = 0u;
#pragma unroll
        for (unsigned j = 0; j < 16; ++j) { const unsigned c = xb_ld(&bar[XB_XCNT(j)]); sum += c; cnt += (c > 0u) ? 1u : 0u; mine = (j == x) ? c : mine; }
        if (sum == G) break;
        __builtin_amdgcn_s_sleep(1);
        if ((++sp & 255u) == 0u) { if (xb_ld(&bar[XB_TMO])) break; if (sp > XB_SPIN_CAP) { atomicAdd(&bar[XB_TMO], 1u); break; } }
    }
    nloc = mine > 0u ? mine : 1u; nx = cnt > 0u ? cnt : 1u;
}

__device__ __forceinline__ void xcd_barrier(const XcdBarrier& b, const bool t0  ) {
    asm volatile("s_waitcnt vmcnt(0)" ::: "memory");
    __syncthreads();
    if (t0) {
        unsigned* bar = b.bar;
        __builtin_amdgcn_s_waitcnt(0);
        unsigned nloc = b.st[0], nx = b.st[1];
        if (nloc == 0u) { xcd_barrier_complete(bar, b.x, nloc, nx); b.st[0] = nloc; b.st[1] = nx; }
        const unsigned old = xb_add(&bar[XB_XSUB(b.x)], 1u);
        const unsigned gen = old / nloc;
        if (old + 1u == (gen + 1u) * nloc) {
            __builtin_amdgcn_fence(__ATOMIC_RELEASE, "agent");
            asm volatile("s_waitcnt vmcnt(0)" ::: "memory");
            const unsigned og = xb_add(&bar[XB_TOP], 1u);
            const unsigned tg = og / nx;
            if (og + 1u == (tg + 1u) * nx) xb_add(&bar[XB_TOPGEN], 1u);
            else XB_SPIN(xb_ld(&bar[XB_TOPGEN]) == tg, bar);
            __builtin_amdgcn_fence(__ATOMIC_ACQUIRE, "agent");
            xb_add(&bar[XB_XGEN(b.x)], 1u);
            asm volatile("s_waitcnt vmcnt(0)" ::: "memory");
        } else {
            XB_SPIN(xb_ld(&bar[XB_XGEN(b.x)]) == gen, bar);
            __builtin_amdgcn_fence(__ATOMIC_ACQUIRE, "agent");
            asm volatile("s_waitcnt vmcnt(0)" ::: "memory");
        }
    }
    __syncthreads();
}


__device__ __forceinline__ float wave_sum(float v, int lane) {
#pragma unroll
    for (int o = 1; o < 64; o <<= 1) v += mk_shfl_xor(v, o, lane);
    return v;
}
__device__ __forceinline__ void sincos_d(double a, float& c_out, float& s_out) {
    const double TWO_PI = 6.283185307179586476925287;
    const double k = __builtin_rint(a / TWO_PI); double r = a - k * TWO_PI; r *= 0.25;
    const double r2 = r * r;
    double s = r * (1.0 + r2 * (-1.0 / 6 + r2 * (1.0 / 120 + r2 * (-1.0 / 5040 + r2 * (1.0 / 362880 + r2 * (-1.0 / 39916800 + r2 * (1.0 / 6227020800.0)))))));
    double c = 1.0 + r2 * (-0.5 + r2 * (1.0 / 24 + r2 * (-1.0 / 720 + r2 * (1.0 / 40320 + r2 * (-1.0 / 3628800 + r2 * (1.0 / 479001600.0 + r2 * (-1.0 / 87178291200.0)))))));
#pragma unroll
    for (int i = 0; i < 2; ++i) { const double s2 = 2.0 * s * c, c2 = c * c - s * s; s = s2; c = c2; }
    c_out = (float)c; s_out = (float)s;
}
__device__ __forceinline__ void row_to_bf16_rs(const float* xrow, bf16* orow, unsigned char* o8row, float* rs, int lane) {
    const GAS f32x4* xr = (const GAS f32x4*)xrow + lane;
    f32x4 v[8]; float s = 0.f;
#pragma unroll
    for (int j = 0; j < 8; ++j) { v[j] = xr[64 * j]; s += (v[j].x * v[j].x + v[j].y * v[j].y) + (v[j].z * v[j].z + v[j].w * v[j].w); }
    const float rstd = __builtin_amdgcn_rsqf(wave_sum(s, lane) * (1.f / DM) + RMS_EPS);
    GAS v2u* o8 = (GAS v2u*)orow + lane;
#pragma unroll
    for (int j = 0; j < 8; ++j) { v2u w; w.x = pk2(v[j].x, v[j].y); w.y = pk2(v[j].z, v[j].w); o8[64 * j] = w; ((GAS unsigned*)o8row + lane)[64 * j] = pk_fp8x4(v[j].x, v[j].y, v[j].z, v[j].w); }
    if (lane == 0) *rs = rstd;
}

__device__ __forceinline__ void norm_res_rows(bf16* Xb, unsigned char* X8, float* out_f32, const bf16* Fb, float* rs, const float* gpost, const bool deferred, const bool write_rs, const bool poison, const int gw, const int NGW, const int lane) {
    f32x4 gp[8];
#pragma unroll
    for (int j = 0; j < 8; ++j) gp[j] = *((const GAS f32x4*)gpost + lane + 64 * j);
    for (int m = gw; m < M; m += NGW) {
        const GAS v2u* fr = (const GAS v2u*)(Fb + (size_t)m * DM) + lane; GAS v2u* xb = (GAS v2u*)(Xb + (size_t)m * DM) + lane;
        f32x4 fv[8], xv[8]; float s = 0.f;
        float epsr = RMS_EPS;
        if (deferred) { const float r = *(const GAS float*)(rs + m); const float t = __builtin_amdgcn_rcpf(r * r); epsr = RMS_EPS * t * t; }
#pragma unroll
        for (int j = 0; j < 8; ++j) { const v2u xw = xb[64 * j]; xv[j] = (f32x4){bflo(xw.x), bfhi(xw.x), bflo(xw.y), bfhi(xw.y)}; }
#pragma unroll
        for (int j = 0; j < 8; ++j) { const v2u fw = fr[64 * j]; fv[j] = (f32x4){bflo(fw.x), bfhi(fw.x), bflo(fw.y), bfhi(fw.y)}; s += (fv[j].x * fv[j].x + fv[j].y * fv[j].y) + (fv[j].z * fv[j].z + fv[j].w * fv[j].w); }
        const float rf = __builtin_amdgcn_rsqf(wave_sum(s, lane) * (1.f / DM) + epsr);
        float s2 = 0.f;
#pragma unroll
        for (int j = 0; j < 8; ++j) { xv[j] = xv[j] + fv[j] * rf * gp[j]; s2 += (xv[j].x * xv[j].x + xv[j].y * xv[j].y) + (xv[j].z * xv[j].z + xv[j].w * xv[j].w); }
        if (out_f32) { GAS f32x4* xo = (GAS f32x4*)(out_f32 + (size_t)m * DM) + lane; const float qn = __builtin_nanf("");
#pragma unroll
            for (int j = 0; j < 8; ++j) xo[64 * j] = poison ? (f32x4){qn, qn, qn, qn} : xv[j]; }
        else {
#pragma unroll
            for (int j = 0; j < 8; ++j) { v2u w; w.x = pk2(xv[j].x, xv[j].y); w.y = pk2(xv[j].z, xv[j].w); xb[64 * j] = w; }
            if (X8) { GAS unsigned* x8 = (GAS unsigned*)(X8 + (size_t)m * DM) + lane;
#pragma unroll
                for (int j = 0; j < 8; ++j) x8[64 * j] = pk_fp8x4(xv[j].x, xv[j].y, xv[j].z, xv[j].w); } }
        if (write_rs) {
            const float rx = __builtin_amdgcn_rsqf(wave_sum(s2, lane) * (1.f / DM) + RMS_EPS);
            if (lane == 0) *(GAS float*)(rs + m) = rx;
        }
    }
}

struct Args { const float* in[15]; float* out; unsigned char* ws; int ph_lo, ph_hi; };
typedef const __attribute__((address_space(4))) Args* kargs_t;
__device__ __forceinline__ kargs_t kargs_() { kargs_t p = (kargs_t)__builtin_amdgcn_kernarg_segment_ptr(); asm volatile("" : "+s"(p)); return p; }
__device__ __forceinline__ int ltid_(int wave_s) { int t = wave_s * 64 + mk_lane(); asm volatile("" : "+v"(t)); return t; }
#define IN_F(k) ((const float*)(const GAS float*)ka->in[k])
#define PHASE_VARS() const kargs_t ka = kargs_(); unsigned char* ws = (unsigned char*)(GAS unsigned char*)ka->ws; int wave_ = wave_s; asm volatile("" : "+s"(wave_)); const int tid = ltid_(wave_s), lane = tid & 63, wave = wave_; \
    const int G = gridDim.x, bx = blockIdx.x, vcu = (G % 8 == 0) ? (bx % 8) * (G / 8) + bx / 8 : bx, gw = vcu * NWAVES + wave, NGW = G * NWAVES; (void)ws; (void)lane; (void)gw; (void)NGW; (void)ka

constexpr int CW_I_IN = (DM / 64) * (INW / 32), CW_I_SQ = (DM / 64) * (DM / 32), CW_I_UP = (DM / 64) * (DFF / 32), CW_I_DN = (DFF / 64) * (DM / 32), CW_I_LAYER = CW_I_IN + 3 * CW_I_SQ + CW_I_UP + CW_I_DN;
__device__ __forceinline__ void convert_weights(const kargs_t ka, unsigned char* ws, LAS float* scr, const int it_first, const int it_end, const int NGW, const int lane) {
    constexpr int I_IN = CW_I_IN, I_SQ = CW_I_SQ, I_UP = CW_I_UP, I_LAYER = CW_I_LAYER;
#define CW_DECODE(it_, src_, dst_, K_, N_, gs_, gf_, f8_) do { const int l_ = (it_) / I_LAYER; int r_ = (it_) % I_LAYER; unsigned char* wl_ = ws + WS_W + (size_t)l_ * W_LAYER; const float* W_; bf16* WT_; gs_ = IN_F(1) + (size_t)l_ * DM; gf_ = false; \
        if (r_ < I_IN) { W_ = IN_F(2) + (size_t)l_ * DM * INW; WT_ = (bf16*)(wl_ + W_IN); K_ = DM; N_ = INW; gf_ = true; } \
        else if ((r_ -= I_IN) < I_SQ) { W_ = IN_F(7) + (size_t)l_ * DM * DM; WT_ = (bf16*)(wl_ + W_OC); K_ = DM; N_ = DM; } \
        else if ((r_ -= I_SQ) < I_SQ) { W_ = IN_F(8) + (size_t)l_ * DM * DM; WT_ = (bf16*)(wl_ + W_OA); K_ = DM; N_ = DM; } \
        else if ((r_ -= I_SQ) < I_SQ) { W_ = IN_F(9) + (size_t)l_ * DM * DM; WT_ = (bf16*)(wl_ + W_MG); K_ = DM; N_ = DM; } \
        else if ((r_ -= I_SQ) < I_UP) { W_ = IN_F(12) + (size_t)l_ * DM * DFF; WT_ = (bf16*)(wl_ + W_UP); K_ = DM; N_ = DFF; gs_ = IN_F(11) + (size_t)l_ * DM; gf_ = true; } \
        else { r_ -= I_UP; W_ = IN_F(13) + (size_t)l_ * DFF * DM; WT_ = (bf16*)(wl_ + W_DN); K_ = DFF; N_ = DM; } \
        const int nblk_ = N_ / 32, k0_ = 64 * (r_ / nblk_), n0_ = 32 * (r_ % nblk_); int ns_ = n0_;     \
        if (N_ == INW && n0_ >= 2048 && n0_ < 6144) { const int q_ = n0_ - 2048, t_ = q_ >> 8, rr_ = q_ & 255; ns_ = ((rr_ >> 7) ? 4096 : 2048) + 128 * t_ + (rr_ & 127); } \
        const bool pf_ = (N_ == INW && n0_ >= 6144 && n0_ < 8704);     \
        if (pf_) { const int wc_ = (n0_ >> 5) & 3; ns_ = (n0_ & ~127) + 64 * (wc_ >> 1) + 16 * (wc_ & 1); } \
        const int q4_ = lane & 7, co_ = pf_ ? (32 * (q4_ & 1) + 4 * (q4_ >> 1)) : 4 * q4_; \
        gs_ += (k0_ % DM) + 8 * (lane & 7);     \
        f8_ = (N_ == INW && n0_ >= N_MAIN);     \
        src_ = W_ + (size_t)(k0_ + (lane >> 3)) * N_ + ns_ + co_; dst_ = (f8_) ? (bf16*)(wl_ + W_G8 + (size_t)(n0_ - N_MAIN) * K_ + k0_) : WT_ + (size_t)n0_ * K_ + k0_; } while (0)
#define CW_LOAD(S, idx_) do { S##ok = (idx_) < it_end; S##i = S##ok ? (idx_) : it_first; const float* s_; const float* gs_; bf16* d_; int K_, N_; bool gf_, f8_; CW_DECODE(S##i, s_, d_, K_, N_, gs_, gf_, f8_); (void)d_; (void)K_; \
        { const f32x4 a_ = *(const GAS f32x4*)(gs_), b_ = *((const GAS f32x4*)(gs_) + 1); const f32x4 one_ = {1.f, 1.f, 1.f, 1.f}; S##g[0] = gf_ ? a_ : one_; S##g[1] = gf_ ? b_ : one_; if (f8_) { S##g[0] *= G8_SCALE; S##g[1] *= G8_SCALE; } } \
        _Pragma("unroll") for (int j_ = 0; j_ < 8; ++j_) S##v[j_] = *(const GAS f32x4*)(s_ + (size_t)(8 * j_) * N_); } while (0)
#define CW_PROCESS(S) do { const float* s_; const float* gs_; bf16* S##d; int S##K, N_; bool gf_, S##f8; { int ix_ = S##i; asm volatile("" : "+s"(ix_)); CW_DECODE(ix_, s_, S##d, S##K, N_, gs_, gf_, S##f8); } (void)s_; (void)gs_; (void)N_; (void)gf_;     \
        { const int rw_ = (lane >> 3) * 33 + 4 * (lane & 7); \
            _Pragma("unroll") for (int j_ = 0; j_ < 8; ++j_) { scr[rw_ + j_ * 8 * 33 + 0] = S##v[j_].x; scr[rw_ + j_ * 8 * 33 + 1] = S##v[j_].y; scr[rw_ + j_ * 8 * 33 + 2] = S##v[j_].z; scr[rw_ + j_ * 8 * 33 + 3] = S##v[j_].w; } } \
        LDS_WAIT(); asm volatile("" ::: "memory"); const int c_ = lane & 7; \
        _Pragma("unroll") for (int j_ = 0; j_ < 4; ++j_) { const int n_ = (lane >> 3) + 8 * j_; const LAS float* sp_ = scr + (8 * c_) * 33 + n_; \
            const float e0_ = sp_[0 * 33] * S##g[0].x, e1_ = sp_[1 * 33] * S##g[0].y, e2_ = sp_[2 * 33] * S##g[0].z, e3_ = sp_[3 * 33] * S##g[0].w, e4_ = sp_[4 * 33] * S##g[1].x, e5_ = sp_[5 * 33] * S##g[1].y, e6_ = sp_[6 * 33] * S##g[1].z, e7_ = sp_[7 * 33] * S##g[1].w; \
            if (S##f8) { v2u o8_; o8_.x = pk_fp8x4(e0_, e1_, e2_, e3_); o8_.y = pk_fp8x4(e4_, e5_, e6_, e7_); *(GAS v2u*)((unsigned char*)(S##d) + (size_t)n_ * (S##K) + 8 * c_) = o8_; } \
            else { v4u o_; o_.x = pk2(e0_, e1_); o_.y = pk2(e2_, e3_); o_.z = pk2(e4_, e5_); o_.w = pk2(e6_, e7_); *(GAS v4u*)((S##d) + (size_t)n_ * (S##K) + 8 * c_) = o_; } } \
        LDS_WAIT(); asm volatile("" ::: "memory"); } while (0)
#define CW_SET(S) f32x4 S##v[8], S##g[2]; int S##i = 0; bool S##ok = false
    CW_SET(a); CW_SET(b); CW_SET(c);
    int it = it_first;
    CW_LOAD(a, it); CW_LOAD(b, it + NGW);
    for (;;) {
        CW_LOAD(c, it + 2 * NGW); if (!aok) break; CW_PROCESS(a);
        CW_LOAD(a, it + 3 * NGW); if (!bok) break; CW_PROCESS(b);
        CW_LOAD(b, it + 4 * NGW); if (!cok) break; CW_PROCESS(c);
        it += 3 * NGW;
    }
#undef CW_SET
#undef CW_PROCESS
#undef CW_LOAD
#undef CW_DECODE
}

__global__ void __launch_bounds__(NWAVES * 64, 2) fwd_kernel(Args args) {
    extern __shared__ __attribute__((aligned(16))) unsigned char lds_raw[];
    LAS unsigned char* lds = (LAS unsigned char*)lds_raw;
    const int wave_s = __builtin_amdgcn_readfirstlane((int)threadIdx.x >> 6);
    {   PHASE_VARS();
        volatile LAS unsigned* MISC = (volatile LAS unsigned*)(lds + MISC_OFF);
        for (int u = tid; u < (LDS_BYTES - LDSCTL_OFF) / 4; u += NWAVES * 64) ((LAS unsigned*)(lds + LDSCTL_OFF))[u] = 0u;
        __syncthreads();
        (void)xcd_barrier_post((unsigned*)(ws + WS_CTL) + CW_BAR, MISC + 8, tid == 0);
    }
#define GRID_BAR() do { XcdBarrier b_; b_.bar = (unsigned*)((unsigned char*)(GAS unsigned char*)kargs_()->ws + WS_CTL) + CW_BAR; unsigned x_ = xb_xcc_id(); asm volatile("" : "+s"(x_)); b_.x = x_; \
    b_.st = (volatile LAS unsigned*)(lds + MISC_OFF) + 8; xcd_barrier(b_, ltid_(wave_s) == 0); } while (0)

#if MK_PER_PHASE
    const int ph_lo = kargs_()->ph_lo, ph_hi = kargs_()->ph_hi;
#define IN(k) (ph_lo <= (k) && (k) < ph_hi)
#else
#define IN(k) true
#endif
#define SEAM(k) do { if (IN(k) && IN((k) + 1)) GRID_BAR(); } while (0)
    if (IN(0)) {   PHASE_VARS();
        convert_weights(ka, ws, (LAS float*)(lds + wave * 16384), gw, CW_I_LAYER, NGW, lane);
        {
            float* rope = (float*)(ws + WS_ROPE);
            const int gid = vcu * (NWAVES * 64) + tid;
            if (gid < 64 * 32) { const int pos = gid >> 5, f = gid & 31;
                double w = 1.0; const double c0 = 0.74989420933245582730218;
                for (int i = 0; i < f; ++i) w *= c0;
                const float wf = (float)w; const float ang = (float)pos * wf;
                float c, s; sincos_d((double)ang, c, s);
                rope[2 * gid] = c; rope[2 * gid + 1] = s; }
        }
        {   const float* x_in = IN_F(0); bf16* Xb = (bf16*)(ws + WS_X); float* rs = (float*)(ws + WS_RS);
            for (int m = gw; m < M; m += NGW) row_to_bf16_rs(x_in + (size_t)m * DM, Xb + (size_t)m * DM, ws + WS_H + (size_t)m * DM, rs + m, lane);
        }
    }
    SEAM(0);

    for (int l = 0; l < DEPTH; ++l) {
        const int pb = 1 + 9 * l;
        if (IN(pb + 0)) {   PHASE_VARS(); unsigned char* wl = ws + WS_W + (size_t)l * W_LAYER;
            pg8::Gemm g{(const bf16*)(ws + WS_X), (const bf16*)(wl + W_IN), M, N_MAIN, DM}; pg8::StaticOrder S; S.init(M, N_MAIN, G, bx, WGM_BIG);
            float m0;
            {   const float* qg_ = IN_F(5) + (size_t)l * HD; const float* kg_ = IN_F(6) + (size_t)l * HD;
                float gq_ = fmaxf(fabsf(qg_[lane]), fabsf(qg_[lane + 64])), gk_ = fmaxf(fabsf(kg_[lane]), fabsf(kg_[lane + 64]));
#pragma unroll
                for (int o_ = 1; o_ < 64; o_ <<= 1) { gq_ = fmaxf(gq_, mk_shfl_xor(gq_, o_, lane)); gk_ = fmaxf(gk_, mk_shfl_xor(gk_, o_, lane)); }
                m0 = __uint_as_float((unsigned)__builtin_amdgcn_readfirstlane((int)__float_as_uint(11.313708499f * gq_ * gk_))); }
            pg8::EpiZ E{(bf16*)(ws + WS_Z), ZW, (const float*)(ws + WS_RS), IN_F(5) + (size_t)l * HD, IN_F(6) + (size_t)l * HD, (const float*)(ws + WS_ROPE),
                        (m0 <= 40.f) ? att::SCALE * 1.4426950408889634f : 1.0f, RMS_EPS, lds + MISC_OFF + 64};
            pg8::gemm_phase<pg8::EpiZ, pg8::StaticOrder, PG8_ALIGN, PG8_SP2>(lds, g, S, E, wave_s);
            {   pg8::Gemm g8{(const bf16*)(ws + WS_H), (const bf16*)(wl + W_G8), M, N_GATE, DM}; pg8::StaticOrder S8; S8.init(M, N_GATE, G, bx, WGM_BIG);
                static_assert(ZW * 2 == 22528 && DM == 2048, "pitches hard-coded in EpiGateZ / EpiGate");
            pg8::EpiGateZ E8{ws + WS_Z + (size_t)Z_GA * 2, IN_F(3) + (size_t)l * 2 * DM, (const float*)(ws + WS_RS), 1.0f / G8_SCALE};
                pg8::gemm_phase<pg8::EpiGateZ, pg8::StaticOrder, PG8_ALIGN, PG8_SP2, true>(lds, g8, S8, E8, wave_s);
            }
        }
        SEAM(pb + 0);
        if (IN(pb + 2)) {   PHASE_VARS();
            bf16* Zb = (bf16*)(ws + WS_Z); bf16* Ob = (bf16*)(ws + WS_O);
            const int nunits = BATCH * NQH * (SEQ / 256), per = (nunits + G - 1) / G;
            float m0;
            {   const float* qg_ = IN_F(5) + (size_t)l * HD; const float* kg_ = IN_F(6) + (size_t)l * HD;
                float gq_ = fmaxf(fabsf(qg_[lane]), fabsf(qg_[lane + 64])), gk_ = fmaxf(fabsf(kg_[lane]), fabsf(kg_[lane + 64]));
#pragma unroll
                for (int o_ = 1; o_ < 64; o_ <<= 1) { gq_ = fmaxf(gq_, mk_shfl_xor(gq_, o_, lane)); gk_ = fmaxf(gk_, mk_shfl_xor(gk_, o_, lane)); }
                m0 = __uint_as_float((unsigned)__builtin_amdgcn_readfirstlane((int)__float_as_uint(11.313708499f * gq_ * gk_))); }
            const bool fixed_ok = (m0 <= 40.f); const float mCfix = -m0 * 1.4426950408889634f;
            for (int i = 0; i < per; ++i) {
                const int u = (G == 256) ? ((vcu >> 5) * 128 + (i >> 1) * 64 + (vcu & 31) * 2 + (i & 1)) : (vcu * per + i);
                if (u >= nunits) break;
                const int bk = u >> 6, b = bk >> 2, kvh = bk & 3, r = u & 63, gq = r >> 4, qb = r & 15, h = kvh * 4 + gq;
                const bf16* Qb = Zb + (size_t)(b * SEQ + qb * 256) * ZW + Z_Q + h * HD;
                const bf16* Kh = Zb + (size_t)(b * SEQ) * ZW + Z_K + kvh * HD;
                const bf16* Vh = Zb + (size_t)(b * SEQ) * ZW + Z_V + kvh * HD;
                bf16* Oo = Ob + (size_t)(b * SEQ + qb * 256) * DM + h * HD;
                if (fixed_ok) att::attn_unit<ZW, ZW, DM, true>(Qb, Kh, Vh, Oo, qb * 256, IN_F(5) + (size_t)l * HD, (const float*)(ws + WS_ROPE), SEQ, (LAS char*)lds, wave_s, mCfix);
                else          att::attn_unit<ZW, ZW, DM, false>(Qb, Kh, Vh, Oo, qb * 256, IN_F(5) + (size_t)l * HD, (const float*)(ws + WS_ROPE), SEQ, (LAS char*)lds, wave_s, 0.f);
                if (l + 1 < DEPTH && i == ((vcu >> 3) % per)) {
                    __syncthreads();
                    const int wv_ = __builtin_amdgcn_readfirstlane(ltid_(wave_s) >> 6);
                    convert_weights(ka, ws, (LAS float*)(lds + wv_ * 16384), (l + 1) * CW_I_LAYER + gw, (l + 2) * CW_I_LAYER, NGW, ltid_(wave_s) & 63);
                    __syncthreads();
                }
            }
            bf16* CAb = (bf16*)(ws + WS_CA);
            {
            const float* cw = IN_F(4) + (size_t)l * 3 * DM;
            const int half = tid >> 8, c0 = (tid & 255) * 8;
            float w0[8], w1[8], w2[8];
#pragma unroll
            for (int e = 0; e < 8; ++e) { w0[e] = cw[c0 + e]; w1[e] = cw[DM + c0 + e]; w2[e] = cw[2 * DM + c0 + e]; }
            for (int unit = vcu; unit < M / 64; unit += G) {
                const int r0 = unit * 64 + half * 32;
                const bf16* zc = Zb + (size_t)r0 * ZW + c0;
                float up[8], uc[8], un[8];
                {   const bool hp = (r0 % SEQ) != 0;
                    const v4u a = *(const GAS v4u*)(zc + Z_U - (hp ? ZW : 0));
                    const float sc = hp ? 1.f : 0.f;
                    up[0] = bflo(a.x) * sc; up[1] = bfhi(a.x) * sc; up[2] = bflo(a.y) * sc; up[3] = bfhi(a.y) * sc; up[4] = bflo(a.z) * sc; up[5] = bfhi(a.z) * sc; up[6] = bflo(a.w) * sc; up[7] = bfhi(a.w) * sc; }
                {   const v4u a = *(const GAS v4u*)(zc + Z_U);
                    uc[0] = bflo(a.x); uc[1] = bfhi(a.x); uc[2] = bflo(a.y); uc[3] = bfhi(a.y); uc[4] = bflo(a.z); uc[5] = bfhi(a.z); uc[6] = bflo(a.w); uc[7] = bfhi(a.w); }
#pragma unroll 4
                for (int i = 0; i < 32; ++i) {
                    const int r = r0 + i; const bool hn = ((r + 1) % SEQ) != 0;
                    const bf16* zr = zc + (size_t)i * ZW;
                    const v4u a = *(const GAS v4u*)(zr + Z_U + (hn ? ZW : 0)), cb = *(const GAS v4u*)(zr + Z_CB);
                    const float sc = hn ? 1.f : 0.f;
                    un[0] = bflo(a.x) * sc; un[1] = bfhi(a.x) * sc; un[2] = bflo(a.y) * sc; un[3] = bfhi(a.y) * sc; un[4] = bflo(a.z) * sc; un[5] = bfhi(a.z) * sc; un[6] = bflo(a.w) * sc; un[7] = bfhi(a.w) * sc;
                    const float cbf[8] = {bflo(cb.x), bfhi(cb.x), bflo(cb.y), bfhi(cb.y), bflo(cb.z), bfhi(cb.z), bflo(cb.w), bfhi(cb.w)};
                    float o[8];
#pragma unroll
                    for (int e = 0; e < 8; ++e) { o[e] = cbf[e] * (w0[e] * up[e] + w1[e] * uc[e] + w2[e] * un[e]); up[e] = uc[e]; uc[e] = un[e]; }
                    v4u w; w.x = pk2(o[0], o[1]); w.y = pk2(o[2], o[3]); w.z = pk2(o[4], o[5]); w.w = pk2(o[6], o[7]);
                    *(GAS v4u*)(CAb + (size_t)r * DM + c0) = w;
                }
            }
            }
            __syncthreads();
        }
        SEAM(pb + 2);
        if (IN(pb + 3)) {   PHASE_VARS(); unsigned char* wl = ws + WS_W + (size_t)l * W_LAYER;
            pg8::Gemm g{(const bf16*)(ws + WS_CA), (const bf16*)(wl + W_OC), M, DM, DM}; pg8::DualOrder S; S.init(M, DM, G, bx, WGM_SQ); S.A2 = (const bf16*)(ws + WS_O); S.Bt2 = (const bf16*)(wl + W_OA);
            pg8::EpiGateDual E{(bf16*)(ws + WS_G), ws + WS_Z + (size_t)Z_GA * 2};
            pg8::gemm_phase<pg8::EpiGateDual, pg8::DualOrder, PG8_ALIGN, PG8_SP2>(lds, g, S, E, wave_s);
        }
        SEAM(pb + 3);
        if (IN(pb + 4)) {   PHASE_VARS(); unsigned char* wl = ws + WS_W + (size_t)l * W_LAYER;
            pg8::Gemm g{(const bf16*)(ws + WS_G), (const bf16*)(wl + W_MG), M, DM, DM}; pg8::StaticOrder S; S.init(M, DM, G, bx, WGM_SQ);
            pg8::EpiBf16<0> E{(bf16*)(ws + WS_F), DM};
            pg8::gemm_phase<pg8::EpiBf16<0>, pg8::StaticOrder, PG8_ALIGN, PG8_SP2>(lds, g, S, E, wave_s);
        }
        SEAM(pb + 4);
        if (IN(pb + 5)) {   PHASE_VARS();
            norm_res_rows((bf16*)(ws + WS_X), nullptr, nullptr, (const bf16*)(ws + WS_F), (float*)(ws + WS_RS), IN_F(10) + (size_t)l * DM, false, true, false, gw, NGW, lane);
        }
        SEAM(pb + 5);
        if (IN(pb + 6)) {   PHASE_VARS(); unsigned char* wl = ws + WS_W + (size_t)l * W_LAYER;
            pg8::Gemm g{(const bf16*)(ws + WS_X), (const bf16*)(wl + W_UP), M, DFF, DM}; pg8::StaticOrder S; S.init(M, DFF, G, bx, WGM_BIG);
            pg8::EpiBf16<1> E{(bf16*)(ws + WS_Z), DFF};
            pg8::gemm_phase<pg8::EpiBf16<1>, pg8::StaticOrder, PG8_ALIGN, PG8_SP2>(lds, g, S, E, wave_s);
        }
        SEAM(pb + 6);
        if (IN(pb + 7)) {   PHASE_VARS(); unsigned char* wl = ws + WS_W + (size_t)l * W_LAYER;
            pg8::Gemm g{(const bf16*)(ws + WS_Z), (const bf16*)(wl + W_DN), M, DM, DFF}; pg8::StaticOrder S; S.init(M, DM, G, bx, 4);
            pg8::EpiBf16<0> E{(bf16*)(ws + WS_F), DM};
            pg8::gemm_phase<pg8::EpiBf16<0>, pg8::StaticOrder, PG8_ALIGN, PG8_SP2>(lds, g, S, E, wave_s);
        }
        SEAM(pb + 7);
        if (IN(pb + 8)) {   PHASE_VARS();
            const bool more = (l + 1 < DEPTH);
            const bool poison = !more && (__hip_atomic_load((unsigned*)(ws + WS_CTL) + CW_BAR + XB_TMO, __ATOMIC_RELAXED, __HIP_MEMORY_SCOPE_AGENT) != 0u);
            norm_res_rows((bf16*)(ws + WS_X), more ? ws + WS_H : nullptr, more ? nullptr : (float*)(GAS float*)ka->out, (const bf16*)(ws + WS_F), (float*)(ws + WS_RS), IN_F(14) + (size_t)l * DM, true, more, poison, gw, NGW, lane);
        }
        if (l + 1 < DEPTH) SEAM(pb + 8);
    }
}


extern "C" void kernel_launch(void* const* d_in, const int* in_sizes, int n_in, void* d_out, int out_size, void* d_ws, size_t ws_size, hipStream_t stream) {
    static int grid = 0;
    if (grid == 0) {
        if (n_in != 15 || in_sizes[0] != M * DM || out_size != M * DM || ws_size < WS_END) {
            fprintf(stderr, "kernel_launch: built for 15 inputs, x/out of %d floats, >= %zu bytes of workspace; got n_in %d, in0 %d, out %d, ws %zu; nothing launched\n", M * DM, (size_t)WS_END, n_in, n_in > 0 ? in_sizes[0] : -1, out_size, ws_size);
            grid = -1; return; }
        int dev = 0, cus = 0, per_cu = 0;
        if (hipGetDevice(&dev) != hipSuccess || hipDeviceGetAttribute(&cus, hipDeviceAttributeMultiprocessorCount, dev) != hipSuccess) { fprintf(stderr, "kernel_launch: device query failed\n"); grid = -1; return; }
        if (hipFuncSetAttribute((const void*)fwd_kernel, hipFuncAttributeMaxDynamicSharedMemorySize, LDS_BYTES) != hipSuccess) { fprintf(stderr, "kernel_launch: hipFuncSetAttribute failed\n"); grid = -1; return; }
        if (hipOccupancyMaxActiveBlocksPerMultiprocessor(&per_cu, (const void*)fwd_kernel, NWAVES * 64, LDS_BYTES) != hipSuccess || per_cu < 1)
            fprintf(stderr, "kernel_launch: note: occupancy query reports %d workgroups per CU\n", per_cu);
        (void)hipGetLastError();
        grid = cus;
    }
    if (grid < 0) return;
    if (hipMemsetAsync((char*)d_ws + WS_CTL, 0, CTL_ZERO_BYTES, stream) != hipSuccess) { fprintf(stderr, "kernel_launch: hipMemsetAsync failed\n"); return; }
    Args a{};
    for (int i = 0; i < 15; ++i) a.in[i] = (const float*)d_in[i];
    a.out = (float*)d_out; a.ws = (unsigned char*)d_ws;
    constexpr int NPHASES = 1 + 9 * DEPTH;
    if (MK_PER_PHASE) { for (int p = 0; p < NPHASES; ++p) { a.ph_lo = p; a.ph_hi = p + 1; hipLaunchKernelGGL(fwd_kernel, dim3(grid), dim3(NWAVES * 64), LDS_BYTES, stream, a); } }
    else { a.ph_lo = 0; a.ph_hi = NPHASES; hipLaunchKernelGGL(fwd_kernel, dim3(grid), dim3(NWAVES * 64), LDS_BYTES, stream, a); }
    const hipError_t le = hipPeekAtLastError();
    if (le != hipSuccess) fprintf(stderr, "kernel_launch: launch failed: %s\n", hipGetErrorName(le));
}
```
